# Optimizing an MI355X kernel written in HIP

```python
import math
import jax, jax.numpy as jnp
from jax import lax
import numpy as np

D_MODEL = 1024
BATCH = 8
SEQ = 8192
DEPTH = 2

D_MIX = D_MODEL
A_HEADS = 8
A_NOPE = 64
A_ROPE = 32
A_V = 64
A_Q_RANK = 384
A_KV_RANK = 256
B_HEADS = 8
B_KV_HEADS = 2
B_HEAD_DIM = 64
B_GROUP = B_HEADS // B_KV_HEADS
WINDOW = 128
BLOCK = 128
REL_BUCKETS = 32
REL_MAX_DIST = 128
D_FF = 2816
FFN_RES_WEIGHT = 0.5
ROPE_THETA = 10000.0
EPS = 1e-6
Q_BLOCK = 128
NEG_INF = -1e30

IN_COLS = A_Q_RANK + A_KV_RANK + A_ROPE + B_HEADS * B_HEAD_DIM + 2 * B_KV_HEADS * B_HEAD_DIM

kernel_name = "hybrid_mla_swa_macaron_encoder"


def rmsnorm(x, g):
    xf = x.astype(jnp.float32)
    y = xf * lax.rsqrt(jnp.mean(xf * xf, axis=-1, keepdims=True) + EPS)
    return (y * g.astype(jnp.float32)).astype(x.dtype)


def swiglu(x, w_gate, w_up, w_down):
    return (jax.nn.silu(x @ w_gate) * (x @ w_up)) @ w_down


def rope_tables(seq):
    pos = jnp.arange(seq, dtype=jnp.float32)
    inv = ROPE_THETA ** (-jnp.arange(0, A_ROPE, 2, dtype=jnp.float32) / A_ROPE)
    ang = pos[:, None] * inv[None, :]
    return jnp.cos(ang), jnp.sin(ang)


def apply_rope(x, cos, sin):
    x1, x2 = jnp.split(x, 2, axis=-1)
    out = jnp.concatenate([x1 * cos - x2 * sin, x2 * cos + x1 * sin], axis=-1)
    return out.astype(x.dtype)


def t5_bucket(rel):
    nb = REL_BUCKETS // 2
    max_exact = nb // 2
    bucket = jnp.where(rel > 0, nb, 0)
    n = jnp.abs(rel)
    nf = jnp.maximum(n, 1).astype(jnp.float32)
    large = max_exact + (jnp.log(nf / max_exact) / math.log(REL_MAX_DIST / max_exact)
                         * (nb - max_exact)).astype(jnp.int32)
    large = jnp.minimum(large, nb - 1)
    return bucket + jnp.where(n < max_exact, n, large)


def band_bias(rel_bias):
    r = jnp.arange(BLOCK)[:, None]
    j = jnp.arange(3 * BLOCK)[None, :]
    rel = j - BLOCK - r
    bias = rel_bias[t5_bucket(rel)]
    bias = jnp.transpose(bias, (2, 0, 1)).reshape(B_KV_HEADS, B_GROUP, BLOCK, 3 * BLOCK)
    in_win = jnp.abs(rel) <= WINDOW
    return bias.astype(jnp.float32), in_win


def mla_attention(c_q, c_kv, k_rope, q_norm_g, w_uq, kv_norm_g, w_ukv, cos, sin):
    B, S, _ = c_q.shape
    q = (rmsnorm(c_q, q_norm_g) @ w_uq).reshape(B, S, A_HEADS, A_NOPE + A_ROPE)
    q_nope, q_rope = q[..., :A_NOPE], q[..., A_NOPE:]
    q_rope = apply_rope(q_rope, cos[None, :, None, :], sin[None, :, None, :])
    kv = (rmsnorm(c_kv, kv_norm_g) @ w_ukv).reshape(B, S, A_HEADS, A_NOPE + A_V)
    k_nope, v = kv[..., :A_NOPE], kv[..., A_NOPE:]
    k_rope = apply_rope(k_rope, cos[None], sin[None])
    scale = (A_NOPE + A_ROPE) ** -0.5
    nblk = S // Q_BLOCK
    qn_b = q_nope.reshape(B, nblk, Q_BLOCK, A_HEADS, A_NOPE).transpose(1, 0, 2, 3, 4)
    qr_b = q_rope.reshape(B, nblk, Q_BLOCK, A_HEADS, A_ROPE).transpose(1, 0, 2, 3, 4)

    def attend(blk):
        qn, qr = blk
        s = (jnp.einsum('bqhd,bkhd->bhqk', qn, k_nope)
             + jnp.einsum('bqhr,bkr->bhqk', qr, k_rope))
        p = jax.nn.softmax(s.astype(jnp.float32) * scale, axis=-1).astype(v.dtype)
        return jnp.einsum('bhqk,bkhd->bqhd', p, v)

    out = lax.map(attend, (qn_b, qr_b))
    return out.transpose(1, 0, 2, 3, 4).reshape(B, S, A_HEADS * A_V)


def window_gqa(q, k, v, sink, bias, in_win):
    B, S, _ = q.shape
    nblk = S // BLOCK
    qb = q.reshape(B, nblk, BLOCK, B_KV_HEADS, B_GROUP, B_HEAD_DIM)

    def banded(t):
        t = t.reshape(B, S, B_KV_HEADS, B_HEAD_DIM)
        tp = jnp.pad(t, ((0, 0), (BLOCK, BLOCK), (0, 0), (0, 0)))
        tp = tp.reshape(B, nblk + 2, BLOCK, B_KV_HEADS, B_HEAD_DIM)
        return jnp.concatenate([tp[:, :-2], tp[:, 1:-1], tp[:, 2:]], axis=2)

    kw, vw = banded(k), banded(v)
    scale = B_HEAD_DIM ** -0.5
    s = jnp.einsum('bnqkgd,bnjkd->bnkgqj', qb, kw).astype(jnp.float32) * scale
    s = s + bias[None, None]
    key_pos = (jnp.arange(nblk)[:, None] - 1) * BLOCK + jnp.arange(3 * BLOCK)[None, :]
    valid = (key_pos >= 0) & (key_pos < S)
    mask = in_win[None, :, :] & valid[:, None, :]
    s = jnp.where(mask[None, :, None, None], s, NEG_INF)
    sk = sink.astype(jnp.float32).reshape(B_KV_HEADS, B_GROUP)[None, None, :, :, None, None]
    m = jnp.maximum(jnp.max(s, axis=-1, keepdims=True), sk)
    p = jnp.exp(s - m)
    p = p / (jnp.sum(p, axis=-1, keepdims=True) + jnp.exp(sk - m))
    out = jnp.einsum('bnkgqj,bnjkd->bnqkgd', p.astype(vw.dtype), vw)
    return out.reshape(B, S, B_HEADS * B_HEAD_DIM)


def setup_inputs(seed: int = 0) -> dict:
    key = jax.random.key(seed)
    ks = iter(jax.random.split(key, 32))

    def w(shape, fan_in):
        return jax.random.normal(next(ks), shape, jnp.float32) * fan_in ** -0.5

    def g(shape):
        return 1.0 + 0.05 * jax.random.normal(next(ks), shape, jnp.float32)

    L = DEPTH
    return {
        "x": jax.random.normal(next(ks), (BATCH, SEQ, D_MODEL), jnp.float32),
        "rel_bias": 0.1 * jax.random.normal(next(ks), (REL_BUCKETS, B_HEADS), jnp.float32),
        "ffn1_pre_g": g((L, D_MODEL)),
        "ffn1_w_gate": w((L, D_MODEL, D_FF), D_MODEL),
        "ffn1_w_up": w((L, D_MODEL, D_FF), D_MODEL),
        "ffn1_w_down": w((L, D_FF, D_MODEL), D_FF),
        "ffn1_post_g": g((L, D_MODEL)),
        "mix_pre_g": g((L, D_MODEL)),
        "w_in": w((L, D_MODEL, IN_COLS), D_MODEL),
        "mla_q_norm_g": g((L, A_Q_RANK)),
        "mla_w_uq": w((L, A_Q_RANK, A_HEADS * (A_NOPE + A_ROPE)), A_Q_RANK),
        "mla_kv_norm_g": g((L, A_KV_RANK)),
        "mla_w_ukv": w((L, A_KV_RANK, A_HEADS * (A_NOPE + A_V)), A_KV_RANK),
        "swa_sink": 0.5 * jax.random.normal(next(ks), (L, B_HEADS), jnp.float32),
        "w_out": w((L, D_MIX, D_MODEL), D_MIX),
        "mix_post_g": g((L, D_MODEL)),
        "ffn2_pre_g": g((L, D_MODEL)),
        "ffn2_w_gate": w((L, D_MODEL, D_FF), D_MODEL),
        "ffn2_w_up": w((L, D_MODEL, D_FF), D_MODEL),
        "ffn2_w_down": w((L, D_FF, D_MODEL), D_FF),
        "ffn2_post_g": g((L, D_MODEL)),
    }


def reference(x, rel_bias, ffn1_pre_g, ffn1_w_gate, ffn1_w_up, ffn1_w_down, ffn1_post_g,
              mix_pre_g, w_in, mla_q_norm_g, mla_w_uq, mla_kv_norm_g, mla_w_ukv, swa_sink,
              w_out, mix_post_g, ffn2_pre_g, ffn2_w_gate, ffn2_w_up, ffn2_w_down, ffn2_post_g):
    S = x.shape[1]
    cos, sin = rope_tables(S)
    bias, in_win = band_bias(rel_bias)
    splits = list(np.cumsum([A_Q_RANK, A_KV_RANK, A_ROPE,
                             B_HEADS * B_HEAD_DIM, B_KV_HEADS * B_HEAD_DIM]))
    for i in range(DEPTH):
        h = rmsnorm(x, ffn1_pre_g[i])
        x = x + FFN_RES_WEIGHT * rmsnorm(swiglu(h, ffn1_w_gate[i], ffn1_w_up[i], ffn1_w_down[i]),
                                         ffn1_post_g[i])
        h = rmsnorm(x, mix_pre_g[i])
        z = h @ w_in[i]
        c_q, c_kv, k_rope, q_b, k_b, v_b = jnp.split(z, splits, axis=-1)
        o_a = mla_attention(c_q, c_kv, k_rope, mla_q_norm_g[i], mla_w_uq[i],
                            mla_kv_norm_g[i], mla_w_ukv[i], cos, sin)
        o_b = window_gqa(q_b, k_b, v_b, swa_sink[i], bias, in_win)
        o = jnp.concatenate([o_a, o_b], axis=-1) @ w_out[i]
        x = x + rmsnorm(o, mix_post_g[i])
        h = rmsnorm(x, ffn2_pre_g[i])
        x = x + FFN_RES_WEIGHT * rmsnorm(swiglu(h, ffn2_w_gate[i], ffn2_w_up[i], ffn2_w_down[i]),
                                         ffn2_post_g[i])
    return x
```

```cpp
#include <hip/hip_runtime.h>
#include <hip/hip_cooperative_groups.h>
#include <cstdio>
#include <cstdint>
namespace cg = cooperative_groups;
__device__ __forceinline__ int opaque_tid(int wv) { unsigned z = 0u; asm volatile("" : "+v"(z)); return (wv << 6) + (int)__builtin_amdgcn_mbcnt_hi(~0u, __builtin_amdgcn_mbcnt_lo(~0u, z)); }
__device__ __forceinline__ float bperm_xor(float v, int lane, int mask) { return __builtin_bit_cast(float, __builtin_amdgcn_ds_bpermute((lane ^ mask) << 2, __builtin_bit_cast(int, v))); }
namespace pg8 {
#define PG8_LAS __attribute__((address_space(3)))
typedef unsigned short bf16_t;
typedef short bf16x8 __attribute__((ext_vector_type(8)));
typedef float f32x4 __attribute__((ext_vector_type(4)));
typedef unsigned u32x4 __attribute__((ext_vector_type(4)));
constexpr int BM = 256, BK = 64, HALF = 128, HTB = HALF * BK * 2  , STAGE_BYTES = 8 * HTB, NXCD = 8, WGM = 8;

__host__ __device__ __forceinline__ int lds_byte(int r, int c) { const int st = (r >> 4) * 2 + (c >> 5), rr = r & 15, cc = c & 31, ob = rr * 64 + cc * 2; return st * 1024 + (ob ^ (((ob >> 9) & 1) << 5)); }
__host__ __device__ __forceinline__ void stage_rc(int b, int& R, int& C) { const int st = b / 1024, sb = b % 1024, swz = sb ^ (((sb >> 9) & 1) << 5); R = (st >> 1) * 16 + swz / 64; C = (st & 1) * 32 + (swz % 64) / 2; }
__host__ __device__ __forceinline__ int perm32(int rho) { const int n = rho >> 4, i = rho & 15; return 8 * (i >> 2) + 4 * n + (i & 3); }

struct Unit { int pm, pn; };
struct Gemm { const bf16_t* A; const bf16_t* Bt; int M, N, K; };

struct StaticOrder {
    int nM, nN, nwg, G, c;
    __host__ __device__ void init(int M, int N, int G_, int c_) { nM = M / BM; nN = N / BM; nwg = nM * nN; G = G_; c = c_; }
    __host__ __device__ bool next(int i, Unit& u) const {
        const long L = (long)i * G + c; if (L >= nwg) return false;
        int wgid = (int)L; { const int q = nwg / NXCD, r = nwg % NXCD, xcd = wgid % NXCD, off = wgid / NXCD; wgid = (xcd < r ? xcd * (q + 1) : r * (q + 1) + (xcd - r) * q) + off; }
        const int nig = WGM * nN, gid = wgid / nig, fm = gid * WGM, gsz = (nM - fm) < WGM ? (nM - fm) : WGM;
        u.pm = fm + ((wgid % nig) % gsz); u.pn = (wgid % nig) / gsz; return true;
    }
    __device__ __forceinline__ void a_ready(const Unit&) const {}
    __device__ __forceinline__ void done(const Unit&) const {}
};

typedef float f32x2 __attribute__((ext_vector_type(2))); typedef __bf16 bf16x2v __attribute__((ext_vector_type(2)));
__device__ __forceinline__ unsigned cvt_pk_bf16(float lo, float hi) { f32x2 v = {lo, hi}; bf16x2v b = __builtin_convertvector(v, bf16x2v); return __builtin_bit_cast(unsigned, b); }
constexpr int SEQ_ = 8192;
__device__ __forceinline__ u32x4 pack8(const f32x4& a, const f32x4& b) { u32x4 w; w.x = cvt_pk_bf16(a[0], a[1]); w.y = cvt_pk_bf16(a[2], a[3]); w.z = cvt_pk_bf16(b[0], b[1]); w.w = cvt_pk_bf16(b[2], b[3]); return w; }
__device__ __forceinline__ float silu_mul(float g, float u) { return g * u * __builtin_amdgcn_rcpf(1.f + __builtin_amdgcn_exp2f(-1.4426950408889634f * g)); }
__device__ __forceinline__ void rope8(f32x4& a, f32x4& b, const f32x4 c4, const f32x4 s4) {
    const f32x4 a0 = a, b0 = b;
    a[0] = a0[0] * c4[0] - a0[1] * s4[0]; a[1] = a0[1] * c4[0] + a0[0] * s4[0];
    a[2] = a0[2] * c4[1] - a0[3] * s4[1]; a[3] = a0[3] * c4[1] + a0[2] * s4[1];
    b[0] = b0[0] * c4[2] - b0[1] * s4[2]; b[1] = b0[1] * c4[2] + b0[0] * s4[2];
    b[2] = b0[2] * c4[3] - b0[3] * s4[3]; b[3] = b0[3] * c4[3] + b0[2] * s4[3];
}
struct EpiStore {
    static constexpr bool PERM = true, AFTER_DRAIN = false;
    bf16_t* O; int ldc;
    __device__ __forceinline__ void operator()(const f32x4 (&acc)[2][2][4][2], const Unit& u, int wr, int wc, int fr, int fq) const {
        const int row0 = u.pm * BM + wr * 64 + fr, col0 = u.pn * BM + wc * 32 + 8 * fq;
#pragma unroll
        for (int ai = 0; ai < 2; ++ai)
#pragma unroll
            for (int m = 0; m < 4; ++m) { bf16_t* rowp = O + (size_t)(row0 + ai * HALF + m * 16) * ldc + col0;
#pragma unroll
                for (int bj = 0; bj < 2; ++bj) *(u32x4*)(rowp + bj * HALF) = pack8(acc[ai][bj][m][0], acc[ai][bj][m][1]); }
    }
};
struct EpiSwiGLU {
    static constexpr bool PERM = true, AFTER_DRAIN = false;
    bf16_t* O; int ldc; const float* rs;
    __device__ __forceinline__ void operator()(const f32x4 (&acc)[2][2][4][2], const Unit& u, int wr, int wc, int fr, int fq) const {
        const int row0 = u.pm * BM + wr * 64 + fr, col0 = u.pn * HALF + wc * 32 + 8 * fq;
#pragma unroll
        for (int ai = 0; ai < 2; ++ai)
#pragma unroll
            for (int m = 0; m < 4; ++m) { f32x4 r0, r1; const float r = rs[row0 + ai * HALF + m * 16];
#pragma unroll
                for (int e = 0; e < 4; ++e) { r0[e] = silu_mul(acc[ai][0][m][0][e] * r, acc[ai][1][m][0][e] * r); r1[e] = silu_mul(acc[ai][0][m][1][e] * r, acc[ai][1][m][1][e] * r); }
                *(u32x4*)(O + (size_t)(row0 + ai * HALF + m * 16) * ldc + col0) = pack8(r0, r1); }
    }
};
struct EpiWin {
    static constexpr bool PERM = true, AFTER_DRAIN = false;
    bf16_t *CQ, *CKV, *KR, *QB, *KB, *VB; float* stat; const float* rope; float qbscale; const float* rs;
    __device__ __forceinline__ void operator()(const f32x4 (&acc)[2][2][4][2], const Unit& u, int wr, int wc, int fr, int fq) const {
        const int row0 = u.pm * BM + wr * 64 + fr;
#pragma unroll
        for (int bj = 0; bj < 2; ++bj) {
            const int c32 = u.pn * BM + bj * HALF + wc * 32;
            if (c32 >= 1440) continue;
            if (c32 < 640) {
                const bool isq = c32 < 384; bf16_t* base = isq ? CQ : CKV; const int ld = isq ? 384 : 256, col = (isq ? c32 : c32 - 384) + 8 * fq;
#pragma unroll
                for (int ai = 0; ai < 2; ++ai)
#pragma unroll
                    for (int m = 0; m < 4; ++m) { const int row = row0 + ai * HALF + m * 16; const float r = rs[row]; const f32x4 a = acc[ai][bj][m][0] * r, b = acc[ai][bj][m][1] * r;
                        *(u32x4*)(base + (size_t)row * ld + col) = pack8(a, b);
                        float s = (a[0] * a[0] + a[1] * a[1]) + (a[2] * a[2] + a[3] * a[3]) + (b[0] * b[0] + b[1] * b[1]) + (b[2] * b[2] + b[3] * b[3]);
                        s += bperm_xor(s, fq * 16 + fr, 16); s += bperm_xor(s, fq * 16 + fr, 32);
                        if (fq == 0) stat[(size_t)row * 20 + (c32 >> 5)] = s; }
            } else if (c32 == 640) {
#pragma unroll
                for (int ai = 0; ai < 2; ++ai)
#pragma unroll
                    for (int m = 0; m < 4; ++m) { const int row = row0 + ai * HALF + m * 16, pos = row & (SEQ_ - 1); const float r = rs[row]; f32x4 a = acc[ai][bj][m][0] * r, b = acc[ai][bj][m][1] * r;
                        const f32x4 c4 = *(const f32x4*)(rope + (size_t)pos * 32 + 4 * fq), s4 = *(const f32x4*)(rope + (size_t)pos * 32 + 16 + 4 * fq);
                        rope8(a, b, c4, s4);
                        *(u32x4*)(KR + (size_t)row * 32 + 8 * fq) = pack8(a, b); }
            } else {
                bf16_t* base; int ld, col; float sc = 1.f;
                if (c32 < 1184) { base = QB; ld = 512; col = c32 - 672; sc = qbscale; } else if (c32 < 1312) { base = KB; ld = 128; col = c32 - 1184; } else { base = VB; ld = 128; col = c32 - 1312; }
                col += 8 * fq;
#pragma unroll
                for (int ai = 0; ai < 2; ++ai)
#pragma unroll
                    for (int m = 0; m < 4; ++m) { const int row = row0 + ai * HALF + m * 16; const float r = rs[row] * sc;
                        *(u32x4*)(base + (size_t)row * ld + col) = pack8(acc[ai][bj][m][0] * r, acc[ai][bj][m][1] * r); }
            }
        }
    }
};
struct EpiUq {
    static constexpr bool PERM = true, AFTER_DRAIN = false;
    bf16_t* Q; const float* stat; const float* rope; float qscale;
    __device__ __forceinline__ void operator()(const f32x4 (&acc)[2][2][4][2], const Unit& u, int wr, int wc, int fr, int fq) const {
        const int row0 = u.pm * BM + wr * 64 + fr;
#pragma unroll
        for (int ai = 0; ai < 2; ++ai)
#pragma unroll
            for (int m = 0; m < 4; ++m) { const int row = row0 + ai * HALF + m * 16, pos = row & (SEQ_ - 1);
                const f32x4* sp = (const f32x4*)(stat + (size_t)row * 20); const f32x4 s0 = sp[0], s1 = sp[1], s2 = sp[2];
                const float ssq = ((s0[0] + s0[1]) + (s0[2] + s0[3])) + ((s1[0] + s1[1]) + (s1[2] + s1[3])) + ((s2[0] + s2[1]) + (s2[2] + s2[3]));
                const float rs = __builtin_amdgcn_rsqf(ssq * (1.0f / 384.0f) + 1e-6f) * qscale;
#pragma unroll
                for (int bj = 0; bj < 2; ++bj) { const int c32 = u.pn * BM + bj * HALF + wc * 32; f32x4 a = acc[ai][bj][m][0] * rs, b = acc[ai][bj][m][1] * rs;
                    if ((c32 % 96) == 64) { const f32x4 c4 = *(const f32x4*)(rope + (size_t)pos * 32 + 4 * fq), s4 = *(const f32x4*)(rope + (size_t)pos * 32 + 16 + 4 * fq); rope8(a, b, c4, s4); }
                    *(u32x4*)(Q + (size_t)row * 768 + c32 + 8 * fq) = pack8(a, b); } }
    }
};
struct EpiUkv {
    static constexpr bool PERM = true, AFTER_DRAIN = false;
    bf16_t *KN, *V; const float* stat;
    __device__ __forceinline__ void operator()(const f32x4 (&acc)[2][2][4][2], const Unit& u, int wr, int wc, int fr, int fq) const {
        const int row0 = u.pm * BM + wr * 64 + fr; const int colt = u.pn * BM; bf16_t* base = colt < 512 ? KN : V; const int col0 = (colt & 511) + wc * 32 + 8 * fq;
#pragma unroll
        for (int ai = 0; ai < 2; ++ai)
#pragma unroll
            for (int m = 0; m < 4; ++m) { const int row = row0 + ai * HALF + m * 16;
                const f32x4* sp = (const f32x4*)(stat + (size_t)row * 20 + 12); const f32x4 s0 = sp[0], s1 = sp[1];
                const float ssq = ((s0[0] + s0[1]) + (s0[2] + s0[3])) + ((s1[0] + s1[1]) + (s1[2] + s1[3]));
                const float rs = __builtin_amdgcn_rsqf(ssq * (1.0f / 256.0f) + 1e-6f);
#pragma unroll
                for (int bj = 0; bj < 2; ++bj) *(u32x4*)(base + (size_t)row * 512 + col0 + bj * HALF) = pack8(acc[ai][bj][m][0] * rs, acc[ai][bj][m][1] * rs); }
    }
};
template <class Epi, class Sched, bool ALIGN_EPI = false, bool SP2 = false>
__device__ __forceinline__ void gemm_phase(PG8_LAS unsigned char* lds, const Gemm g, const Sched& S, const Epi& E, const int wv) {
    const int tid = opaque_tid(wv), wid = __builtin_amdgcn_readfirstlane(tid >> 6), lane = tid & 63, wr = wid >> 2, wc = wid & 3, fr = lane & 15, fq = lane >> 4;
    const int K = g.K, nt = K / BK;
    unsigned voffA[2], voffB[2];
#pragma unroll
    for (int i = 0; i < 2; ++i) { int R, C; stage_rc(tid * 16 + i * 8192, R, C); const int Rb = Epi::PERM ? ((R & ~31) + perm32(R & 31)) : R;
        voffA[i] = (unsigned)(R * K + C) * 2u; voffB[i] = (unsigned)(Rb * K + C) * 2u; }
    const size_t kstep = (size_t)(BK * 2);
    const size_t hstep = (size_t)HALF * K * 2;
    const size_t tstep = 2 * hstep;
    const unsigned ldsw = (unsigned)wid * 1024u;
    const int aoff = lds_byte(wr * 64 + fr, fq * 8), boff = lds_byte(wc * 32 + fr, fq * 8);
#define PG8_SA(b, h) (((b) * 2 + (h)) * HTB)
#define PG8_SB(b, h) ((4 + (b) * 2 + (h)) * HTB)
#define PG8_STAGE(bufoff, gbase, voff) do { _Pragma("unroll") for (int _i = 0; _i < 2; ++_i) \
        __builtin_amdgcn_global_load_lds((const unsigned*)((const char*)(gbase) + (voff)[_i]), (PG8_LAS unsigned*)(lds + (bufoff) + ldsw + _i * 8192), 16, 0, 0); } while (0)
#define PG8_LDA(dst, b, h) do { _Pragma("unroll") for (int m = 0; m < 4; ++m) _Pragma("unroll") for (int k = 0; k < 2; ++k) dst[m][k] = *(const PG8_LAS bf16x8*)(lds + PG8_SA(b, h) + aoff + m * 2048 + k * 1024); } while (0)
#define PG8_LDB(dst, b, h) do { _Pragma("unroll") for (int n = 0; n < 2; ++n) _Pragma("unroll") for (int k = 0; k < 2; ++k) dst[n][k] = *(const PG8_LAS bf16x8*)(lds + PG8_SB(b, h) + boff + n * 2048 + k * 1024); } while (0)
#define PG8_MMA(ai, bj, At, Bt) do { __builtin_amdgcn_s_setprio(1); _Pragma("unroll") for (int m = 0; m < 4; ++m) _Pragma("unroll") for (int n = 0; n < 2; ++n) _Pragma("unroll") for (int k = 0; k < 2; ++k) \
        acc[ai][bj][m][n] = __builtin_amdgcn_mfma_f32_16x16x32_bf16(Bt[n][k], At[m][k], acc[ai][bj][m][n], 0, 0, 0); __builtin_amdgcn_s_setprio(0); } while (0)
#define PG8_WAIT_V(n) asm volatile("s_waitcnt vmcnt(" #n ")" ::: "memory")
#define PG8_WAIT_L(n) asm volatile("s_waitcnt lgkmcnt(" #n ")" ::: "memory")
#define PG8_BAR __builtin_amdgcn_s_barrier()
#define PG8_SCHED __builtin_amdgcn_sched_barrier(0)
    Unit cur, nxt; int ui = 0;
    if (!S.next(0, cur)) return;
    f32x4 acc[2][2][4][2];
#pragma unroll
    for (int a = 0; a < 2; ++a)
#pragma unroll
        for (int b = 0; b < 2; ++b)
#pragma unroll
            for (int m = 0; m < 4; ++m)
#pragma unroll
                for (int n = 0; n < 2; ++n) acc[a][b][m][n] = (f32x4){0.f, 0.f, 0.f, 0.f};
    bf16x8 At[4][2], B0[2][2], B1[2][2];
    const char* cA = (const char*)g.A + (size_t)cur.pm * tstep; const char* cB = (const char*)g.Bt + (size_t)cur.pn * tstep;
    S.a_ready(cur);
    if constexpr (SP2) {
        PG8_STAGE(PG8_SB(0, 0), cB, voffB); PG8_STAGE(PG8_SB(0, 1), cB + hstep, voffB); PG8_STAGE(PG8_SA(0, 0), cA, voffA); PG8_STAGE(PG8_SA(0, 1), cA + hstep, voffA);
        if (wr == 1) PG8_BAR;
        PG8_WAIT_V(2); PG8_BAR;
        PG8_STAGE(PG8_SB(1, 0), cB + kstep, voffB); PG8_STAGE(PG8_SA(1, 0), cA + kstep, voffA); PG8_STAGE(PG8_SB(1, 1), cB + hstep + kstep, voffB);
        PG8_WAIT_V(6); PG8_BAR;
    } else {
        PG8_STAGE(PG8_SB(0, 0), cB, voffB); PG8_STAGE(PG8_SA(0, 0), cA, voffA); PG8_STAGE(PG8_SB(0, 1), cB + hstep, voffB); PG8_STAGE(PG8_SA(0, 1), cA + hstep, voffA);
        if (wr == 1) PG8_BAR;
        PG8_WAIT_V(4); PG8_BAR;
        PG8_STAGE(PG8_SB(1, 0), cB + kstep, voffB); PG8_STAGE(PG8_SA(1, 0), cA + kstep, voffA); PG8_STAGE(PG8_SB(1, 1), cB + hstep + kstep, voffB);
        PG8_WAIT_V(6); PG8_BAR;
    }
    for (;;) {
        const bool has_next = S.next(ui + 1, nxt);
        const char* nA = has_next ? (const char*)g.A + (size_t)nxt.pm * tstep : cA; const char* nB = has_next ? (const char*)g.Bt + (size_t)nxt.pn * tstep : cB;
        for (int t = 0; t < nt; t += 2) {
            const bool last = (t == nt - 2);
            const char* a1 = cA + (size_t)(t + 1) * kstep;
            const char* a2 = last ? nA : cA + (size_t)(t + 2) * kstep; const char* b2 = last ? nB : cB + (size_t)(t + 2) * kstep;
            const char* a3 = a2 + kstep; const char* b3 = b2 + kstep;
            if (last && has_next) S.a_ready(nxt);
            if constexpr (SP2) {
            PG8_LDB(B0, 0, 0); PG8_LDB(B1, 0, 1); PG8_SCHED; PG8_LDA(At, 0, 0); PG8_STAGE(PG8_SA(1, 1), a1 + hstep, voffA);
            PG8_WAIT_V(8); PG8_WAIT_L(0); PG8_BAR; PG8_MMA(0, 0, At, B0); PG8_MMA(0, 1, At, B1); PG8_BAR; PG8_SCHED;
            PG8_LDA(At, 0, 1); PG8_STAGE(PG8_SB(0, 0), b2, voffB); PG8_STAGE(PG8_SB(0, 1), b2 + hstep, voffB); PG8_STAGE(PG8_SA(0, 0), a2, voffA);
            PG8_WAIT_V(8); PG8_WAIT_L(0); PG8_BAR; PG8_MMA(1, 0, At, B0); PG8_MMA(1, 1, At, B1); PG8_BAR; PG8_SCHED;
            PG8_LDB(B0, 1, 0); PG8_LDB(B1, 1, 1); PG8_SCHED; PG8_LDA(At, 1, 0); PG8_STAGE(PG8_SA(0, 1), a2 + hstep, voffA);
            PG8_WAIT_V(8); PG8_WAIT_L(0); PG8_BAR; PG8_MMA(0, 0, At, B0); PG8_MMA(0, 1, At, B1); PG8_BAR; PG8_SCHED;
            PG8_LDA(At, 1, 1); PG8_STAGE(PG8_SB(1, 0), b3, voffB); PG8_STAGE(PG8_SB(1, 1), b3 + hstep, voffB); PG8_STAGE(PG8_SA(1, 0), a3, voffA);
            PG8_WAIT_V(8); PG8_WAIT_L(0); PG8_BAR; PG8_MMA(1, 0, At, B0); PG8_MMA(1, 1, At, B1); PG8_BAR; PG8_SCHED;
            } else {
            PG8_LDB(B0, 0, 0); PG8_SCHED; PG8_LDA(At, 0, 0); PG8_STAGE(PG8_SA(1, 1), a1 + hstep, voffA);
            PG8_WAIT_L(8); PG8_BAR; PG8_WAIT_L(0); PG8_MMA(0, 0, At, B0); PG8_BAR; PG8_SCHED;
            PG8_LDB(B1, 0, 1); PG8_STAGE(PG8_SB(0, 0), b2, voffB);
            PG8_BAR; PG8_WAIT_L(0); PG8_MMA(0, 1, At, B1); PG8_BAR;
            PG8_LDA(At, 0, 1); PG8_STAGE(PG8_SA(0, 0), a2, voffA);
            PG8_BAR; PG8_WAIT_L(0); PG8_MMA(1, 0, At, B0); PG8_BAR; PG8_SCHED;
            PG8_STAGE(PG8_SB(0, 1), b2 + hstep, voffB);
            PG8_WAIT_V(6); PG8_BAR; PG8_MMA(1, 1, At, B1); PG8_BAR;
            PG8_LDB(B0, 1, 0); PG8_SCHED; PG8_LDA(At, 1, 0); PG8_STAGE(PG8_SA(0, 1), a2 + hstep, voffA);
            PG8_WAIT_L(8); PG8_BAR; PG8_WAIT_L(0); PG8_MMA(0, 0, At, B0); PG8_BAR; PG8_SCHED;
            PG8_LDB(B1, 1, 1); PG8_STAGE(PG8_SB(1, 0), b3, voffB);
            PG8_BAR; PG8_WAIT_L(0); PG8_MMA(0, 1, At, B1); PG8_BAR;
            PG8_LDA(At, 1, 1); PG8_STAGE(PG8_SA(1, 0), a3, voffA);
            PG8_BAR; PG8_WAIT_L(0); PG8_MMA(1, 0, At, B0); PG8_BAR; PG8_SCHED;
            PG8_STAGE(PG8_SB(1, 1), b3 + hstep, voffB);
            PG8_WAIT_V(6); PG8_BAR; PG8_MMA(1, 1, At, B1); PG8_BAR;
            }
        }
        if constexpr (ALIGN_EPI) { if (wr == 0) PG8_BAR; }
        if constexpr (!Epi::AFTER_DRAIN) { E(acc, cur, wr, wc, fr, fq); S.done(cur); }
        if (!has_next) break;
#pragma unroll
        for (int a = 0; a < 2; ++a)
#pragma unroll
            for (int b = 0; b < 2; ++b)
#pragma unroll
                for (int m = 0; m < 4; ++m)
#pragma unroll
                    for (int n = 0; n < 2; ++n) acc[a][b][m][n] = (f32x4){0.f, 0.f, 0.f, 0.f};
        cur = nxt; cA = nA; cB = nB; ++ui;
        if constexpr (ALIGN_EPI) { if (wr == 1) PG8_BAR; }
    }
    PG8_WAIT_V(0);
    if constexpr (!ALIGN_EPI) { if (wr == 0) PG8_BAR; }
    PG8_BAR;
    if constexpr (Epi::AFTER_DRAIN) { E.fused(acc, cur, wr, wc, fr, fq, lds, wid, lane); S.done(cur); }
#undef PG8_SA
#undef PG8_SB
#undef PG8_STAGE
#undef PG8_LDA
#undef PG8_LDB
#undef PG8_MMA
#undef PG8_WAIT_V
#undef PG8_WAIT_L
#undef PG8_BAR
#undef PG8_SCHED
}
}
#define LAS __attribute__((address_space(3)))
typedef unsigned short bf16;
typedef short bf16x8 __attribute__((ext_vector_type(8)));
typedef float f32x4 __attribute__((ext_vector_type(4)));
typedef float f32x16 __attribute__((ext_vector_type(16)));
typedef unsigned u32x4 __attribute__((ext_vector_type(4)));
typedef unsigned u32x2 __attribute__((ext_vector_type(2)));

constexpr int BATCH = 8, SEQ = 8192, DM = 1024, MTOK = BATCH * SEQ, FF = 2816, DEPTH = 2;
constexpr int QRANK = 384, KVRANK = 256, INCOLS = 1440, INPAD = 1536;
constexpr float EPS = 1e-6f, LOG2E = 1.4426950408889634f;
constexpr float QSCALE_A = 0.10206207261596575f * LOG2E;
constexpr float QSCALE_B = 0.125f * LOG2E;
constexpr int NWAVES = 8, NTHREADS = 512;
constexpr int LDS_BYTES = 147456;

constexpr size_t MiB = 1u << 20;
constexpr size_t CTL_ZERO_BYTES = 64 * 1024; constexpr int CW_GRP = 8192;
constexpr size_t WS_ROPE = 1 * MiB, WS_BTAB = 2 * MiB, WS_RS = 2 * MiB + 256 * 1024;
constexpr size_t WS_W = 4 * MiB, WL_BYTES = 40 * MiB;
constexpr size_t WO_GU1 = 0, WO_D1 = 11 * MiB, WO_GU2 = 16 * MiB + MiB / 2, WO_D2 = 27 * MiB + MiB / 2, WO_WIN = 33 * MiB, WO_UQ = 36 * MiB, WO_UKV = 37 * MiB, WO_OUT = 38 * MiB;
constexpr size_t WS_Y = 212 * MiB, WS_BIG = 340 * MiB;
constexpr size_t SLICE = 67 * MiB;
constexpr size_t OFF_ACT = 0;
constexpr size_t OFF_CQ = 0, OFF_CKV = 6 * MiB, OFF_KR = 10 * MiB, OFF_QB = 11 * MiB, OFF_KB = 19 * MiB, OFF_VB = 21 * MiB, OFF_Q = 23 * MiB, OFF_KN = 35 * MiB, OFF_V = 43 * MiB, OFF_O = 51 * MiB;
constexpr size_t WS_STAT = WS_BIG + 8 * SLICE, WS_XB = WS_STAT + 6 * MiB, WS_END = WS_XB + 128 * MiB;
#define GB(ws, grp, OFF, LD) ((ws) + WS_BIG + (size_t)(grp) * (SLICE - (size_t)SEQ * (LD) * 2) + (OFF))

__device__ __forceinline__ unsigned f2bf(float f) { unsigned u = __builtin_bit_cast(unsigned, f); return (u + 0x7fffu + ((u >> 16) & 1u)) >> 16; }
__device__ __forceinline__ unsigned pk2(float lo, float hi) { return f2bf(lo) | (f2bf(hi) << 16); }
__device__ __forceinline__ float bf2f(unsigned h) { return __builtin_bit_cast(float, h << 16); }
__device__ __forceinline__ float wave_sum(float v, int lane) {
#pragma unroll
    for (int o = 1; o < 64; o <<= 1) v += bperm_xor(v, lane, o);
    return v;
}

__device__ __forceinline__ int map_col(int mat, int r, const float* W0, const float* W1, const float*& src) {
    src = W0;
    switch (mat) {
    case 0: { const int t = r >> 8, w = r & 255; if (w >= 128) src = W1; return t * 128 + (w & 127); }
    case 2: { if (r >= INCOLS) return -1; if (r >= 640 && r < 672) { const int idx = r - 640; return 640 + (idx >> 1) + 16 * (idx & 1); } return r; }
    case 3: { const int h = r / 96, w = r % 96; if (w < 64) return h * 96 + w; const int idx = w - 64; return h * 96 + 64 + (idx >> 1) + 16 * (idx & 1); }
    case 4: { if (r < 512) return (r >> 6) * 128 + (r & 63); const int r2 = r - 512; return (r2 >> 6) * 128 + 64 + (r2 & 63); }
    default: return r;
    }
}
__device__ __forceinline__ void tr_item(int mat, const float* W0, const float* W1, int N, int K, int NP, const float* gk, bf16* WT, int item, LAS float* scr, int lane) {
    const int nblk = NP / 32, kb = item / nblk, nb = item % nblk, k0 = 64 * kb, n0 = 32 * nb;
    const float* src; const int col = map_col(mat, n0 + (lane & 31), W0, W1, src);
#pragma unroll 8
    for (int i = 0; i < 32; ++i) { const int kk = 2 * i + (lane >> 5); float v = 0.f; if (col >= 0) v = src[(size_t)(k0 + kk) * N + col]; if (gk) v *= gk[k0 + kk]; scr[kk * 33 + (lane & 31)] = v; }
    asm volatile("s_waitcnt lgkmcnt(0)" ::: "memory");
    const int c = lane & 7;
#pragma unroll
    for (int j = 0; j < 4; ++j) { const int n = (lane >> 3) + 8 * j; const LAS float* s = scr + (8 * c) * 33 + n;
        u32x4 o; o.x = pk2(s[0 * 33], s[1 * 33]); o.y = pk2(s[2 * 33], s[3 * 33]); o.z = pk2(s[4 * 33], s[5 * 33]); o.w = pk2(s[6 * 33], s[7 * 33]);
        *(u32x4*)(WT + (size_t)(n0 + n) * K + k0 + 8 * c) = o; }
    asm volatile("s_waitcnt lgkmcnt(0)" ::: "memory");
}

struct Args { const float* in[21]; float* out; unsigned char* ws; int pad0, pad1; };
typedef const Args __attribute__((address_space(4)))* ArgP;

__device__ __forceinline__ void row_to_bf16_rs(const float* xrow, bf16* orow, float* rs, int lane) {
    const f32x4* xr = (const f32x4*)xrow + lane; f32x4 v[4]; float s = 0.f;
#pragma unroll
    for (int j = 0; j < 4; ++j) { v[j] = __builtin_nontemporal_load(xr + 64 * j); s += (v[j][0] * v[j][0] + v[j][1] * v[j][1]) + (v[j][2] * v[j][2] + v[j][3] * v[j][3]); }
    const float rstd = __builtin_amdgcn_rsqf(wave_sum(s, lane) * (1.f / DM) + EPS);
#pragma unroll
    for (int j = 0; j < 4; ++j) { u32x2 o; o.x = pk2(v[j][0], v[j][1]); o.y = pk2(v[j][2], v[j][3]); ((u32x2*)orow)[lane + 64 * j] = o; }
    if (lane == 0) *rs = rstd;
}

__device__ __forceinline__ int t5_bucket(int rel) {
    const int n = rel < 0 ? -rel : rel; int b = rel > 0 ? 16 : 0;
    const float nf = (float)(n > 1 ? n : 1);
    int large = 8 + (int)(logf(nf / 8.0f) / 2.772588722239781f * 8.0f);
    large = large < 15 ? large : 15;
    return b + (n < 8 ? n : large);
}

__device__ __forceinline__ void prologue(ArgP a, LAS unsigned char* lds, int gw, int NGW, int lane, int wave) {
    LAS float* scr = (LAS float*)(lds + wave * 16384);
    unsigned char* ws = a->ws;
    constexpr int I_GU = 16 * 176, I_D = 44 * 32, I_WIN = 16 * 48, I_UQ = 6 * 24, I_UKV = 4 * 32, I_OUT = 16 * 32;
    constexpr int PER_L = 2 * I_GU + 2 * I_D + I_WIN + I_UQ + I_UKV + I_OUT;
    for (int it = gw; it < DEPTH * PER_L; it += NGW) {
        const int L = it / PER_L; int r = it % PER_L; unsigned char* wl = ws + WS_W + (size_t)L * WL_BYTES;
        if (r < I_GU) { tr_item(0, a->in[3] + (size_t)L * DM * FF, a->in[4] + (size_t)L * DM * FF, FF, DM, 2 * FF, a->in[2] + L * DM, (bf16*)(wl + WO_GU1), r, scr, lane); continue; } r -= I_GU;
        if (r < I_D) { tr_item(1, a->in[5] + (size_t)L * FF * DM, nullptr, DM, FF, DM, nullptr, (bf16*)(wl + WO_D1), r, scr, lane); continue; } r -= I_D;
        if (r < I_GU) { tr_item(0, a->in[17] + (size_t)L * DM * FF, a->in[18] + (size_t)L * DM * FF, FF, DM, 2 * FF, a->in[16] + L * DM, (bf16*)(wl + WO_GU2), r, scr, lane); continue; } r -= I_GU;
        if (r < I_D) { tr_item(1, a->in[19] + (size_t)L * FF * DM, nullptr, DM, FF, DM, nullptr, (bf16*)(wl + WO_D2), r, scr, lane); continue; } r -= I_D;
        if (r < I_WIN) { tr_item(2, a->in[8] + (size_t)L * DM * INCOLS, nullptr, INCOLS, DM, INPAD, a->in[7] + L * DM, (bf16*)(wl + WO_WIN), r, scr, lane); continue; } r -= I_WIN;
        if (r < I_UQ) { tr_item(3, a->in[10] + (size_t)L * QRANK * 768, nullptr, 768, QRANK, 768, a->in[9] + L * QRANK, (bf16*)(wl + WO_UQ), r, scr, lane); continue; } r -= I_UQ;
        if (r < I_UKV) { tr_item(4, a->in[12] + (size_t)L * KVRANK * 1024, nullptr, 1024, KVRANK, 1024, a->in[11] + L * KVRANK, (bf16*)(wl + WO_UKV), r, scr, lane); continue; } r -= I_UKV;
        tr_item(1, a->in[14] + (size_t)L * DM * DM, nullptr, DM, DM, DM, nullptr, (bf16*)(wl + WO_OUT), r, scr, lane);
    }
    float* rope = (float*)(ws + WS_ROPE);
    for (int e = gw * 64 + lane; e < SEQ * 16; e += NGW * 64) {
        const int pos = e >> 4, i = e & 15; const int i4 = i & 3, i16 = i >> 2;
        double inv = i4 == 0 ? 1.0 : i4 == 1 ? 0.5623413251903491 : i4 == 2 ? 0.31622776601683794 : 0.1778279410038923;
        inv *= i16 == 0 ? 1.0 : i16 == 1 ? 0.1 : i16 == 2 ? 0.01 : 0.001;
        const double rev = (double)pos * inv * 0.15915494309189535; const float fr = (float)(rev - floor(rev));
        rope[pos * 32 + i] = __builtin_amdgcn_cosf(fr); rope[pos * 32 + 16 + i] = __builtin_amdgcn_sinf(fr);
    }
    float* bt = (float*)(ws + WS_BTAB);
    for (int e = gw * 64 + lane; e < 8 * 260; e += NGW * 64) { const int h = e / 260, idx = e % 260; bt[e] = (idx >= 1 && idx <= 257) ? a->in[1][t5_bucket(idx - 129) * 8 + h] * LOG2E : -1e30f; }
    for (int m0 = gw; m0 < MTOK; m0 += 2 * NGW) {
        f32x4 v[2][4]; float s[2] = {0.f, 0.f};
#pragma unroll
        for (int q = 0; q < 2; ++q) { const f32x4* xr = (const f32x4*)(a->in[0] + (size_t)(m0 + q * NGW) * DM) + lane;
#pragma unroll
            for (int j = 0; j < 4; ++j) v[q][j] = __builtin_nontemporal_load(xr + 64 * j); }
#pragma unroll
        for (int q = 0; q < 2; ++q) { const int m = m0 + q * NGW;
#pragma unroll
            for (int j = 0; j < 4; ++j) { s[q] += (v[q][j][0] * v[q][j][0] + v[q][j][1] * v[q][j][1]) + (v[q][j][2] * v[q][j][2] + v[q][j][3] * v[q][j][3]);
                u32x2 o; o.x = pk2(v[q][j][0], v[q][j][1]); o.y = pk2(v[q][j][2], v[q][j][3]); ((u32x2*)((bf16*)(ws + WS_XB) + (size_t)m * DM))[lane + 64 * j] = o; } }
        const float r0 = __builtin_amdgcn_rsqf(wave_sum(s[0], lane) * (1.f / DM) + EPS), r1 = __builtin_amdgcn_rsqf(wave_sum(s[1], lane) * (1.f / DM) + EPS);
        if (lane == 0) { ((float*)(ws + WS_RS))[m0] = r0; ((float*)(ws + WS_RS))[m0 + NGW] = r1; }
    }
}

template <bool XIN_BF, bool XOUT_BF>
__device__ __forceinline__ void norm_pass(const bf16* Y, const void* xsrc_, void* xdst_, const float* gpost, float w, float* rs, int mstart, int mend, int mstep, int lane) {
    f32x4 gp[4];
#pragma unroll
    for (int j = 0; j < 4; ++j) gp[j] = ((const f32x4*)gpost)[lane + 64 * j] * w;
    for (int m0 = mstart; m0 < mend; m0 += 2 * mstep) {
        f32x4 y[2][4], x[2][4]; float s[2] = {0.f, 0.f};
#pragma unroll
        for (int q = 0; q < 2; ++q) { const int m = m0 + q * mstep; const u32x2* yr = (const u32x2*)(Y + (size_t)m * DM) + lane;
#pragma unroll
            for (int j = 0; j < 4; ++j) { const u32x2 t = __builtin_nontemporal_load(yr + 64 * j);
                if (XIN_BF) { const u32x2 tx = ((const u32x2*)((const bf16*)xsrc_ + (size_t)m * DM))[lane + 64 * j]; x[q][j][0] = bf2f(tx.x & 0xffffu); x[q][j][1] = bf2f(tx.x >> 16); x[q][j][2] = bf2f(tx.y & 0xffffu); x[q][j][3] = bf2f(tx.y >> 16); }
                else x[q][j] = __builtin_nontemporal_load((const f32x4*)((const float*)xsrc_ + (size_t)m * DM) + lane + 64 * j);
                y[q][j][0] = bf2f(t.x & 0xffffu); y[q][j][1] = bf2f(t.x >> 16); y[q][j][2] = bf2f(t.y & 0xffffu); y[q][j][3] = bf2f(t.y >> 16); } }
#pragma unroll
        for (int q = 0; q < 2; ++q)
#pragma unroll
            for (int j = 0; j < 4; ++j) s[q] += (y[q][j][0] * y[q][j][0] + y[q][j][1] * y[q][j][1]) + (y[q][j][2] * y[q][j][2] + y[q][j][3] * y[q][j][3]);
        float rstd[2]; rstd[0] = __builtin_amdgcn_rsqf(wave_sum(s[0], lane) * (1.f / DM) + EPS); rstd[1] = __builtin_amdgcn_rsqf(wave_sum(s[1], lane) * (1.f / DM) + EPS);
        float s2[2] = {0.f, 0.f};
#pragma unroll
        for (int q = 0; q < 2; ++q) { const int m = m0 + q * mstep;
#pragma unroll
            for (int j = 0; j < 4; ++j) { x[q][j] = x[q][j] + y[q][j] * gp[j] * rstd[q];
                if (XOUT_BF) { u32x2 o; o.x = pk2(x[q][j][0], x[q][j][1]); o.y = pk2(x[q][j][2], x[q][j][3]); ((u32x2*)((bf16*)xdst_ + (size_t)m * DM))[lane + 64 * j] = o; }
                else __builtin_nontemporal_store(x[q][j], (f32x4*)((float*)xdst_ + (size_t)m * DM) + lane + 64 * j);
                s2[q] += (x[q][j][0] * x[q][j][0] + x[q][j][1] * x[q][j][1]) + (x[q][j][2] * x[q][j][2] + x[q][j][3] * x[q][j][3]); } }
        if (rs) { const float r0 = __builtin_amdgcn_rsqf(wave_sum(s2[0], lane) * (1.f / DM) + EPS), r1 = __builtin_amdgcn_rsqf(wave_sum(s2[1], lane) * (1.f / DM) + EPS);
            if (lane == 0) { rs[m0] = r0; rs[m0 + mstep] = r1; } }
    }
}

constexpr int KROWB = 208, VROWB = 192, ATT_KBYTES = 64 * KROWB, ATT_VBYTES = 64 * VROWB, ATT_VBASE = 2 * ATT_KBYTES, ATT_BT_OFF = ATT_VBASE + 2 * ATT_VBYTES + 1024, ATT_OST_OFF = 61440;
struct AttnT { const bf16* Q; int ldq; const bf16* K; int ldk; const bf16* KR; const bf16* V; int ldv; bf16* O; };
typedef short v4i16_t __attribute__((ext_vector_type(4)));
__device__ __forceinline__ float hswap_max(float v) { auto rr = __builtin_amdgcn_permlane32_swap(__float_as_uint(v), __float_as_uint(v), false, false); return fmaxf(__uint_as_float(rr[0]), __uint_as_float(rr[1])); }
__device__ __forceinline__ float hswap_sum(float v) { auto rr = __builtin_amdgcn_permlane32_swap(__float_as_uint(v), __float_as_uint(v), false, false); return __uint_as_float(rr[0]) + __uint_as_float(rr[1]); }
typedef float f32x2_t __attribute__((ext_vector_type(2))); typedef __bf16 bf16x2_t __attribute__((ext_vector_type(2)));
__device__ __forceinline__ unsigned cvtpk(float lo, float hi) { f32x2_t v = {lo, hi}; bf16x2_t b = __builtin_convertvector(v, bf16x2_t); return __builtin_bit_cast(unsigned, b); }
__device__ __forceinline__ v4i16_t vtr(const LAS unsigned char* p) { return __builtin_amdgcn_ds_read_tr16_b64_v4i16((LAS v4i16_t*)p); }
#define ATT_SBAR() __builtin_amdgcn_sched_barrier(0)

template <int MODE>
__device__ __forceinline__ void attn_unit(LAS unsigned char* lds, const AttnT& T, int b, int q0, int qcol, int kcol, int vcol, int ocol, float sink_l2, const LAS float* btab, const int wv) {
    constexpr int KS = MODE == 0 ? 6 : 4;
    const int tid = opaque_tid(wv), lane = tid & 63, l32 = lane & 31, hi = lane >> 5; const int wid = __builtin_amdgcn_readfirstlane(tid >> 6);
    const size_t rowbase = (size_t)b * SEQ;
    if (wid >= 4) __builtin_amdgcn_s_setprio(1);
    bf16x8 qr[KS];
    { const bf16* qrow = T.Q + (rowbase + q0 + wid * 32 + l32) * T.ldq + qcol + hi * 8;
#pragma unroll
      for (int ks = 0; ks < KS; ++ks) qr[ks] = *(const bf16x8*)(qrow + ks * 16); }
    int kvs, NT;
    if (MODE == 0) { kvs = 0; NT = SEQ / 64; } else { const int tlo = q0 == 0 ? 2 : 0, thi = (q0 + 384 > SEQ) ? 6 : 8; kvs = q0 - 128 + 64 * tlo; NT = thi - tlo; }
    const int srow = tid >> 3, sc = tid & 7, rr = tid >> 2, rc = tid & 3; const bool rrole = MODE == 0 && tid < 256;
    const bf16* vsrc = T.V + (rowbase + kvs + srow) * T.ldv + vcol + 8 * sc;
    const bf16* ksrc = T.K + (rowbase + kvs + srow) * T.ldk + kcol + 8 * sc;
    const bf16* rsrc = MODE == 0 ? T.KR + (rowbase + kvs + rr) * 32 + 8 * rc : nullptr;
    u32x4 st0, st1, st2;
#define ATT_LOADK(t) do { st0 = *(const u32x4*)(ksrc + (size_t)(t) * 64 * T.ldk); if (rrole) st2 = *(const u32x4*)(rsrc + (size_t)(t) * 64 * 32); } while (0)
#define ATT_LOADV(t) do { st1 = *(const u32x4*)(vsrc + (size_t)(t) * 64 * T.ldv); } while (0)
#define ATT_STOREK(slot) do { LAS unsigned char* kb_ = lds + (slot) * ATT_KBYTES; *(LAS u32x4*)(kb_ + srow * KROWB + 16 * sc) = st0; if (rrole) *(LAS u32x4*)(kb_ + rr * KROWB + 128 + 16 * rc) = st2; } while (0)
#define ATT_STOREV(slot) do { *(LAS u32x4*)(lds + ATT_VBASE + (slot) * ATT_VBYTES + srow * VROWB + 16 * sc) = st1; } while (0)
    const int pim = (l32 & 0x13) | ((l32 & 4) << 1) | ((l32 & 8) >> 1);
    const int koff = pim * KROWB + hi * 16;
    const int voff = ATT_VBASE + (8 * hi + ((lane & 15) >> 2)) * VROWB + (16 * ((lane >> 4) & 1) + 4 * (lane & 3)) * 2;
    float mrun = MODE == 1 ? sink_l2 : 0.f, lsum = (MODE == 1 && hi == 0) ? 1.f : 0.f;
    f32x16 o0 = {}, o1 = {}, pA0, pA1, pB0, pB1, negm;
    const int qpos = q0 + wid * 32 + l32;
    bf16x8 kf[2 * KS]; v4i16_t vl[8], vh[8]; u32x4 w0, w1, w2, w3;
#define ATT_KREAD(slot) do { const LAS unsigned char* kb_ = lds + (slot) * ATT_KBYTES; \
        _Pragma("unroll") for (int ks = 0; ks < KS; ++ks) { kf[2 * ks] = *(const LAS bf16x8*)(kb_ + koff + ks * 32); kf[2 * ks + 1] = *(const LAS bf16x8*)(kb_ + koff + 32 * KROWB + ks * 32); } } while (0)
#define ATT_KRD(slot, ks) do { const LAS unsigned char* kb_ = lds + (slot) * ATT_KBYTES; kf[2 * (ks)] = *(const LAS bf16x8*)(kb_ + koff + (ks) * 32); kf[2 * (ks) + 1] = *(const LAS bf16x8*)(kb_ + koff + 32 * KROWB + (ks) * 32); } while (0)
#define ATT_VREAD(i, vb_) do { const LAS unsigned char* vp_ = (vb_) + voff + ((i) >> 1) * 16 * VROWB + ((i) & 1) * 64; vl[i] = vtr(vp_); vh[i] = vtr(vp_ + 4 * VROWB); } while (0)
#define ATT_VF(i) (bf16x8){vl[i][0], vl[i][1], vl[i][2], vl[i][3], vh[i][0], vh[i][1], vh[i][2], vh[i][3]}
#define ATT_MM(acc, a_, b_) acc = __builtin_amdgcn_mfma_f32_32x32x16_bf16(a_, b_, acc, 0, 0, 0)
#define ATT_EP(P, r, W, wi) do { P[r] = __builtin_amdgcn_exp2f(P[r]); P[(r) + 1] = __builtin_amdgcn_exp2f(P[(r) + 1]); lacc += P[r]; lacc += P[(r) + 1]; W[wi] = cvtpk(P[r], P[(r) + 1]); } while (0)
#define ATT_SM4(P0, P1, r, kvb_) do { if (MODE == 1) { _Pragma("unroll") for (int r_ = (r); r_ < (r) + 2; ++r_) { \
                const int j0 = (kvb_) + 16 * (r_ >> 3) + 8 * hi + (r_ & 7) - qpos + 129, j1 = j0 + 32; \
                const int i0 = j0 < 0 ? 0 : (j0 > 258 ? 258 : j0), i1 = j1 < 0 ? 0 : (j1 > 258 ? 258 : j1); \
                P0[r_] += btab[i0]; P1[r_] += btab[i1]; } } } while (0)
#define ATT_DECIDE(P0, P1, lacc_) do { const float lt_ = hswap_max(lacc_); \
        if (__any(lt_ > 65536.f)) { const float dl = lt_ > 65536.f ? (float)__builtin_amdgcn_frexp_expf(lt_) : 0.f, al = __builtin_amdgcn_exp2f(-dl); mrun += dl; lsum *= al; \
            _Pragma("unroll") for (int r = 0; r < 16; ++r) { o0[r] *= al; o1[r] *= al; P0[r] -= dl; P1[r] -= dl; negm[r] = -mrun; } } } while (0)
#define ATT_STEP(PC0, PC1, PN0, PN1, tt) do { \
        const int kslot_ = (tt) & 1; const bool kmore_ = (tt) + 2 < NT; const LAS unsigned char* vb_ = lds + ((tt) & 1) * ATT_VBYTES; const int kvn_ = kvs + 64 * ((tt) + 1); \
        if ((tt) + 3 < NT) ATT_LOADK((tt) + 3); ATT_LOADV((tt) + 1); \
        float lacc = 0.f; ATT_SBAR(); \
        PN0 = __builtin_amdgcn_mfma_f32_32x32x16_bf16(kf[0], qr[0], negm, 0, 0, 0); ATT_EP(PC0, 0, w0, 0); ATT_EP(PC0, 2, w0, 1); ATT_SBAR(); \
        PN1 = __builtin_amdgcn_mfma_f32_32x32x16_bf16(kf[1], qr[0], negm, 0, 0, 0); ATT_EP(PC0, 4, w0, 2); ATT_EP(PC0, 6, w0, 3); ATT_SBAR(); \
        ATT_MM(PN0, kf[2], qr[1]); ATT_EP(PC0, 8, w1, 0); ATT_EP(PC0, 10, w1, 1); ATT_SBAR(); \
        ATT_MM(PN1, kf[3], qr[1]); ATT_EP(PC0, 12, w1, 2); ATT_EP(PC0, 14, w1, 3); ATT_SBAR(); \
        ATT_MM(PN0, kf[4], qr[2]); ATT_EP(PC1, 0, w2, 0); ATT_VREAD(0, vb_); ATT_VREAD(1, vb_); ATT_SBAR(); \
        ATT_MM(PN1, kf[5], qr[2]); ATT_EP(PC1, 2, w2, 1); ATT_VREAD(2, vb_); ATT_SBAR(); \
        ATT_MM(PN0, kf[6], qr[3]); ATT_EP(PC1, 4, w2, 2); ATT_VREAD(3, vb_); ATT_SBAR(); \
        ATT_MM(PN1, kf[7], qr[3]); ATT_EP(PC1, 6, w2, 3); ATT_VREAD(4, vb_); ATT_SBAR(); \
        if (KS > 4) { ATT_MM(PN0, kf[2 * KS - 4], qr[KS - 2]); ATT_EP(PC1, 8, w3, 0); ATT_VREAD(5, vb_); ATT_SBAR(); \
                      ATT_MM(PN1, kf[2 * KS - 3], qr[KS - 2]); ATT_EP(PC1, 10, w3, 1); ATT_VREAD(6, vb_); ATT_SBAR(); \
                      ATT_MM(PN0, kf[2 * KS - 2], qr[KS - 1]); ATT_EP(PC1, 12, w3, 2); ATT_VREAD(7, vb_); ATT_SBAR(); \
                      ATT_MM(PN1, kf[2 * KS - 1], qr[KS - 1]); ATT_EP(PC1, 14, w3, 3); ATT_SBAR(); } \
        else { ATT_EP(PC1, 8, w3, 0); ATT_EP(PC1, 10, w3, 1); ATT_VREAD(5, vb_); ATT_VREAD(6, vb_); ATT_EP(PC1, 12, w3, 2); ATT_EP(PC1, 14, w3, 3); ATT_VREAD(7, vb_); ATT_SBAR(); } \
        lsum += lacc; \
        ATT_MM(o0, ATT_VF(0), __builtin_bit_cast(bf16x8, w0)); ATT_SM4(PN0, PN1, 0, kvn_); if (kmore_) ATT_KRD(kslot_, 0); ATT_SBAR(); \
        ATT_MM(o1, ATT_VF(1), __builtin_bit_cast(bf16x8, w0)); ATT_SM4(PN0, PN1, 2, kvn_); if (kmore_) ATT_KRD(kslot_, 1); ATT_SBAR(); \
        ATT_MM(o0, ATT_VF(2), __builtin_bit_cast(bf16x8, w1)); ATT_SM4(PN0, PN1, 4, kvn_); if (kmore_) ATT_KRD(kslot_, 2); ATT_SBAR(); \
        ATT_MM(o1, ATT_VF(3), __builtin_bit_cast(bf16x8, w1)); ATT_SM4(PN0, PN1, 6, kvn_); if (kmore_) ATT_KRD(kslot_, 3); ATT_SBAR(); \
        ATT_MM(o0, ATT_VF(4), __builtin_bit_cast(bf16x8, w2)); ATT_SM4(PN0, PN1, 8, kvn_); if (KS > 4) { if (kmore_) ATT_KRD(kslot_, KS - 2); } ATT_SBAR(); \
        ATT_MM(o1, ATT_VF(5), __builtin_bit_cast(bf16x8, w2)); ATT_SM4(PN0, PN1, 10, kvn_); if (KS > 4) { if (kmore_) ATT_KRD(kslot_, KS - 1); } ATT_SBAR(); \
        ATT_MM(o0, ATT_VF(6), __builtin_bit_cast(bf16x8, w3)); ATT_SM4(PN0, PN1, 12, kvn_); ATT_SBAR(); \
        ATT_MM(o1, ATT_VF(7), __builtin_bit_cast(bf16x8, w3)); ATT_SM4(PN0, PN1, 14, kvn_); ATT_SBAR(); \
        ATT_DECIDE(PN0, PN1, lacc); \
        if ((tt) + 3 < NT) ATT_STOREK(((tt) + 1) & 1); ATT_STOREV(((tt) + 1) & 1); \
        __syncthreads(); } while (0)
    ATT_LOADK(0); ATT_LOADV(0); ATT_STOREK(0); ATT_STOREV(0); ATT_LOADK(1); ATT_STOREK(1);
    __syncthreads();
    ATT_KREAD(0); ATT_SBAR();
    pA0 = __builtin_amdgcn_mfma_f32_32x32x16_bf16(kf[0], qr[0], (f32x16){}, 0, 0, 0); pA1 = __builtin_amdgcn_mfma_f32_32x32x16_bf16(kf[1], qr[0], (f32x16){}, 0, 0, 0);
#pragma unroll
    for (int ks = 1; ks < KS; ++ks) { ATT_MM(pA0, kf[2 * ks], qr[ks]); ATT_MM(pA1, kf[2 * ks + 1], qr[ks]); }
#pragma unroll
    for (int r = 0; r < 16; ++r) { pA0[r] -= mrun; pA1[r] -= mrun; }
#pragma unroll
    for (int r = 0; r < 16; r += 2) ATT_SM4(pA0, pA1, r, kvs);
    if (MODE == 0) {
        float rm = fmaxf(fmaxf(pA0[0], pA1[0]), fmaxf(pA0[1], pA1[1]));
#pragma unroll
        for (int r = 2; r < 16; r += 2) rm = fmaxf(fmaxf(rm, fmaxf(pA0[r], pA1[r])), fmaxf(pA0[r + 1], pA1[r + 1]));
        rm = hswap_max(rm); mrun = rm;
#pragma unroll
        for (int r = 0; r < 16; ++r) { pA0[r] -= rm; pA1[r] -= rm; }
    }
#pragma unroll
    for (int r = 0; r < 16; ++r) negm[r] = -mrun;
    ATT_KREAD(1);
    __syncthreads();
    ATT_LOADK(2); ATT_STOREK(0);
    __syncthreads();
    for (int t = 0; t + 2 < NT; t += 2) { ATT_STEP(pA0, pA1, pB0, pB1, t); ATT_STEP(pB0, pB1, pA0, pA1, t + 1); }
    ATT_STEP(pA0, pA1, pB0, pB1, NT - 2);
    {
        const LAS unsigned char* vb_ = lds + ((NT - 1) & 1) * ATT_VBYTES; float lacc = 0.f;
#pragma unroll
        for (int i = 0; i < 8; ++i) ATT_VREAD(i, vb_);
        ATT_EP(pB0, 0, w0, 0); ATT_EP(pB0, 2, w0, 1); ATT_EP(pB0, 4, w0, 2); ATT_EP(pB0, 6, w0, 3); ATT_EP(pB0, 8, w1, 0); ATT_EP(pB0, 10, w1, 1); ATT_EP(pB0, 12, w1, 2); ATT_EP(pB0, 14, w1, 3);
        ATT_EP(pB1, 0, w2, 0); ATT_EP(pB1, 2, w2, 1); ATT_EP(pB1, 4, w2, 2); ATT_EP(pB1, 6, w2, 3); ATT_EP(pB1, 8, w3, 0); ATT_EP(pB1, 10, w3, 1); ATT_EP(pB1, 12, w3, 2); ATT_EP(pB1, 14, w3, 3);
        lsum += lacc;
        ATT_MM(o0, ATT_VF(0), __builtin_bit_cast(bf16x8, w0)); ATT_MM(o1, ATT_VF(1), __builtin_bit_cast(bf16x8, w0)); ATT_MM(o0, ATT_VF(2), __builtin_bit_cast(bf16x8, w1)); ATT_MM(o1, ATT_VF(3), __builtin_bit_cast(bf16x8, w1));
        ATT_MM(o0, ATT_VF(4), __builtin_bit_cast(bf16x8, w2)); ATT_MM(o1, ATT_VF(5), __builtin_bit_cast(bf16x8, w2)); ATT_MM(o0, ATT_VF(6), __builtin_bit_cast(bf16x8, w3)); ATT_MM(o1, ATT_VF(7), __builtin_bit_cast(bf16x8, w3));
        __syncthreads();
    }
#undef ATT_LOADK
#undef ATT_LOADV
#undef ATT_STOREK
#undef ATT_STOREV
#undef ATT_KREAD
#undef ATT_VREAD
#undef ATT_VF
#undef ATT_MM
#undef ATT_EP
#undef ATT_SM4
#undef ATT_DECIDE
#undef ATT_STEP
    __builtin_amdgcn_s_setprio(0);
    const float inv = 1.0f / hswap_sum(lsum);
    const int lane2 = opaque_tid(wv) & 63, l32b = lane2 & 31, hib = lane2 >> 5;
    LAS unsigned char* stg = lds + ATT_OST_OFF + wid * (32 * 144);
#pragma unroll
    for (int g = 0; g < 4; ++g) {
        u32x2 a, c; a.x = cvtpk(o0[4 * g] * inv, o0[4 * g + 1] * inv); a.y = cvtpk(o0[4 * g + 2] * inv, o0[4 * g + 3] * inv);
        c.x = cvtpk(o1[4 * g] * inv, o1[4 * g + 1] * inv); c.y = cvtpk(o1[4 * g + 2] * inv, o1[4 * g + 3] * inv);
        *(LAS u32x2*)(stg + l32b * 144 + (8 * g + 4 * hib) * 2) = a; *(LAS u32x2*)(stg + l32b * 144 + 64 + (8 * g + 4 * hib) * 2) = c;
    }
    bf16* obase = T.O + (rowbase + q0 + wid * 32) * DM + ocol;
#pragma unroll
    for (int i = 0; i < 4; ++i) { const int row = i * 8 + (lane2 >> 3), ch = lane2 & 7;
        const u32x4 v = *(const LAS u32x4*)(stg + row * 144 + ch * 16); *(u32x4*)(obase + (size_t)row * DM + ch * 8) = v; }
}
__device__ __forceinline__ void group_barrier(unsigned* word, unsigned& gen, unsigned nmem, const int wv) {
    asm volatile("s_waitcnt vmcnt(0)" ::: "memory");
    __syncthreads();
    if (opaque_tid(wv) == 0) {
        __builtin_amdgcn_fence(__ATOMIC_RELEASE, "agent");
        asm volatile("s_waitcnt vmcnt(0)" ::: "memory");
        const unsigned want = nmem * (gen + 1u);
        (void)__hip_atomic_fetch_add(word, 1u, __ATOMIC_RELAXED, __HIP_MEMORY_SCOPE_AGENT);
        unsigned sp = 0u;
        while (__hip_atomic_load(word, __ATOMIC_RELAXED, __HIP_MEMORY_SCOPE_AGENT) < want) { __builtin_amdgcn_s_sleep(1); if (++sp > (1u << 22)) break; }
        __builtin_amdgcn_fence(__ATOMIC_ACQUIRE, "agent");
        asm volatile("s_waitcnt vmcnt(0)" ::: "memory");
    }
    gen += 1u;
    __syncthreads();
}

#ifndef MK_SYNC
#define MK_SYNC() group_barrier(gword, ggen, gmem, wv)
#endif
#define ARGP() ({ ArgP p_ = (ArgP)__builtin_amdgcn_kernarg_segment_ptr(); asm volatile("" : "+s"(p_)); p_; })
#define PH_IDS() const int tid = opaque_tid(wv), lane = tid & 63; const int wave = __builtin_amdgcn_readfirstlane(tid >> 6); const int gw = vcu * NWAVES + wave, NGW = G * NWAVES; (void)lane; (void)gw; (void)NGW
__global__ void __launch_bounds__(NTHREADS) mk_fwd(Args a_unused) {
    extern __shared__ __attribute__((aligned(16))) unsigned char lds_raw[];
    LAS unsigned char* lds = (LAS unsigned char*)lds_raw;
    cg::grid_group grid = cg::this_grid();
    const int wv = __builtin_amdgcn_readfirstlane(threadIdx.x >> 6);
    const int G = gridDim.x, bx = blockIdx.x; const int vcu = (G % 8 == 0) ? (bx % 8) * (G / 8) + bx / 8 : bx;
    const int grp = bx & 7, lcu = bx >> 3;
    unsigned* gword = (unsigned*)(ARGP()->ws) + CW_GRP + 64 * grp; unsigned ggen = 0u; const unsigned gmem = 32u;

    { PH_IDS(); ArgP ap = ARGP(); prologue(ap, lds, gw, NGW, lane, wave); }
    grid.sync();
    for (int L = 0; L < DEPTH; ++L) {
        for (int f = 0; f < 2; ++f) {
            { ArgP ap = ARGP(); unsigned char* ws = ap->ws; const unsigned char* wl = ws + WS_W + (size_t)L * WL_BYTES;
              pg8::Gemm g{(const bf16*)(ws + WS_XB), (const bf16*)(wl + (f ? WO_GU2 : WO_GU1)), MTOK, 2 * FF, DM}; pg8::StaticOrder S; S.init(MTOK, 2 * FF, G, bx);
              pg8::EpiSwiGLU E{(bf16*)(GB(ws, grp, OFF_ACT, FF)), FF, (const float*)(ws + WS_RS)}; pg8::gemm_phase<pg8::EpiSwiGLU, pg8::StaticOrder, true, true>(lds, g, S, E, wv); }
            MK_SYNC();
            { ArgP ap = ARGP(); unsigned char* ws = ap->ws; const unsigned char* wl = ws + WS_W + (size_t)L * WL_BYTES;
              pg8::Gemm g{(const bf16*)(GB(ws, grp, OFF_ACT, FF)), (const bf16*)(wl + (f ? WO_D2 : WO_D1)), MTOK, DM, FF}; pg8::StaticOrder S; S.init(MTOK, DM, G, bx);
              pg8::EpiStore E{(bf16*)(ws + WS_Y), DM}; pg8::gemm_phase<pg8::EpiStore, pg8::StaticOrder, true, true>(lds, g, S, E, wv); }
            MK_SYNC();
            { PH_IDS(); ArgP ap = ARGP(); unsigned char* ws = ap->ws; bf16* XB = (bf16*)(ws + WS_XB);
              const int mstart = SEQ * grp + lcu * NWAVES + wave, mend = SEQ * (grp + 1), mstep = 32 * NWAVES;
              const float* gpost = f ? ap->in[20] + L * DM : ap->in[6] + L * DM; float* rs = (float*)(ws + WS_RS);
              if (L == 0 && f == 0) norm_pass<false, true>((const bf16*)(ws + WS_Y), ap->in[0], XB, gpost, 0.5f, rs, mstart, mend, mstep, lane);
              else if (L == DEPTH - 1 && f == 1) norm_pass<true, false>((const bf16*)(ws + WS_Y), XB, ap->out, gpost, 0.5f, nullptr, mstart, mend, mstep, lane);
              else norm_pass<true, true>((const bf16*)(ws + WS_Y), XB, XB, gpost, 0.5f, rs, mstart, mend, mstep, lane); }
            if (f == 1) { if (L + 1 < DEPTH) MK_SYNC(); continue; }
            MK_SYNC();
            { ArgP ap = ARGP(); unsigned char* ws = ap->ws; const unsigned char* wl = ws + WS_W + (size_t)L * WL_BYTES;
              pg8::Gemm g{(const bf16*)(ws + WS_XB), (const bf16*)(wl + WO_WIN), MTOK, INPAD, DM}; pg8::StaticOrder S; S.init(MTOK, INPAD, G, bx);
              pg8::EpiWin E{(bf16*)(GB(ws, grp, OFF_CQ, 384)), (bf16*)(GB(ws, grp, OFF_CKV, 256)), (bf16*)(GB(ws, grp, OFF_KR, 32)), (bf16*)(GB(ws, grp, OFF_QB, 512)), (bf16*)(GB(ws, grp, OFF_KB, 128)), (bf16*)(GB(ws, grp, OFF_VB, 128)), (float*)(ws + WS_STAT), (const float*)(ws + WS_ROPE), QSCALE_B, (const float*)(ws + WS_RS)};
              pg8::gemm_phase<pg8::EpiWin, pg8::StaticOrder, true, true>(lds, g, S, E, wv); }
            MK_SYNC();
            { ArgP ap = ARGP(); unsigned char* ws = ap->ws; const unsigned char* wl = ws + WS_W + (size_t)L * WL_BYTES;
              pg8::Gemm g{(const bf16*)(GB(ws, grp, OFF_CQ, 384)), (const bf16*)(wl + WO_UQ), MTOK, 768, QRANK}; pg8::StaticOrder S; S.init(MTOK, 768, G, bx);
              pg8::EpiUq E{(bf16*)(GB(ws, grp, OFF_Q, 768)), (const float*)(ws + WS_STAT), (const float*)(ws + WS_ROPE), QSCALE_A}; pg8::gemm_phase<pg8::EpiUq, pg8::StaticOrder, true, true>(lds, g, S, E, wv); }
            { ArgP ap = ARGP(); unsigned char* ws = ap->ws; const unsigned char* wl = ws + WS_W + (size_t)L * WL_BYTES;
              pg8::Gemm g{(const bf16*)(GB(ws, grp, OFF_CKV, 256)), (const bf16*)(wl + WO_UKV), MTOK, 1024, KVRANK}; pg8::StaticOrder S; S.init(MTOK, 1024, G, bx);
              pg8::EpiUkv E{(bf16*)(GB(ws, grp, OFF_KN, 512)), (bf16*)(GB(ws, grp, OFF_V, 512)), (const float*)(ws + WS_STAT)}; pg8::gemm_phase<pg8::EpiUkv, pg8::StaticOrder, true, true>(lds, g, S, E, wv); }
            {
              PH_IDS(); ArgP ap = ARGP(); unsigned char* ws = ap->ws; const float* btab = (const float*)(ws + WS_BTAB); const float* sink = ap->in[13] + L * 8;
              LAS float* bt = (LAS float*)(lds + ATT_BT_OFF);
              for (int e = tid; e < 8 * 260; e += NTHREADS) bt[e] = btab[e];
              __syncthreads();
              const AttnT T{(const bf16*)(GB(ws, grp, OFF_QB, 512)), 512, (const bf16*)(GB(ws, grp, OFF_KB, 128)), 128, nullptr, (const bf16*)(GB(ws, grp, OFF_VB, 128)), 128, (bf16*)(GB(ws, grp, OFF_O, 1024))};
              for (int u = lcu; u < 256; u += 32) { const int h = u >> 5, qb = u & 31, b = grp;
                  attn_unit<1>(lds, T, b, qb * 256, h * 64, (h >> 2) * 64, (h >> 2) * 64, 512 + h * 64, sink[h] * LOG2E, bt + h * 260, wv); } }
            MK_SYNC();
            { ArgP ap = ARGP(); unsigned char* ws = ap->ws;
              const AttnT T{(const bf16*)(GB(ws, grp, OFF_Q, 768)), 768, (const bf16*)(GB(ws, grp, OFF_KN, 512)), 512, (const bf16*)(GB(ws, grp, OFF_KR, 32)), (const bf16*)(GB(ws, grp, OFF_V, 512)), 512, (bf16*)(GB(ws, grp, OFF_O, 1024))};
              for (int u = lcu; u < 256; u += 32) { const int h = u >> 5, qb = u & 31, b = grp;
                  attn_unit<0>(lds, T, b, qb * 256, h * 96, h * 64, h * 64, h * 64, 0.f, nullptr, wv); } }
            MK_SYNC();
            { ArgP ap = ARGP(); unsigned char* ws = ap->ws; const unsigned char* wl = ws + WS_W + (size_t)L * WL_BYTES;
              pg8::Gemm g{(const bf16*)(GB(ws, grp, OFF_O, 1024)), (const bf16*)(wl + WO_OUT), MTOK, DM, DM}; pg8::StaticOrder S; S.init(MTOK, DM, G, bx);
              pg8::EpiStore E{(bf16*)(ws + WS_Y), DM}; pg8::gemm_phase<pg8::EpiStore, pg8::StaticOrder, true, true>(lds, g, S, E, wv); }
            MK_SYNC();
            { PH_IDS(); ArgP ap = ARGP(); unsigned char* ws = ap->ws; bf16* XB = (bf16*)(ws + WS_XB);
              const int mstart = SEQ * grp + lcu * NWAVES + wave, mend = SEQ * (grp + 1), mstep = 32 * NWAVES;
              norm_pass<true, true>((const bf16*)(ws + WS_Y), XB, XB, ap->in[15] + L * DM, 1.0f, (float*)(ws + WS_RS), mstart, mend, mstep, lane); }
            MK_SYNC();
        }
    }
}

extern "C" void kernel_launch(void* const* d_in, const int* in_sizes, int n_in, void* d_out, int out_size, void* d_ws, size_t ws_size, hipStream_t stream) {
    static int grid = 0;
    if (grid == 0) {
        if (n_in != 21 || in_sizes[0] != MTOK * DM || out_size != MTOK * DM || ws_size < WS_END) { fprintf(stderr, "kernel_launch: unexpected shapes / workspace (n_in %d, ws %zu)\n", n_in, ws_size); grid = -1; return; }
        int dev = 0, cus = 0, per_cu = 0;
        (void)hipGetDevice(&dev); (void)hipDeviceGetAttribute(&cus, hipDeviceAttributeMultiprocessorCount, dev);
        (void)hipFuncSetAttribute((const void*)mk_fwd, hipFuncAttributeMaxDynamicSharedMemorySize, LDS_BYTES);
        if (hipOccupancyMaxActiveBlocksPerMultiprocessor(&per_cu, (const void*)mk_fwd, NTHREADS, LDS_BYTES) != hipSuccess || per_cu < 1) per_cu = 1;
        (void)hipGetLastError();
        grid = cus * per_cu;
        if (grid < 256) { fprintf(stderr, "kernel_launch: this kernel needs 256 co-resident workgroups (got %d)\n", grid); grid = -1; return; }
        grid = 256;
    }
    if (grid < 0) return;
    if (hipMemsetAsync(d_ws, 0, CTL_ZERO_BYTES, stream) != hipSuccess) { fprintf(stderr, "kernel_launch: memset of the barrier words failed\n"); return; }
    Args a{};
    for (int i = 0; i < 21; ++i) a.in[i] = (const float*)d_in[i];
    a.out = (float*)d_out; a.ws = (unsigned char*)d_ws;
    void* args[] = {&a};
    hipError_t e = hipLaunchCooperativeKernel((const void*)mk_fwd, dim3(grid), dim3(NTHREADS), args, LDS_BYTES, stream);
    if (e != hipSuccess) fprintf(stderr, "cooperative launch failed: %s (grid %d)\n", hipGetErrorString(e), grid);
}
```

```cpp
#include <hip/hip_runtime.h>
#include <hip/hip_cooperative_groups.h>
#include <cstdio>
#include <cstdint>
namespace cg = cooperative_groups;
__device__ __forceinline__ int opaque_tid(int wv) { unsigned z = 0u; asm volatile("" : "+v"(z)); return (wv << 6) + (int)__builtin_amdgcn_mbcnt_hi(~0u, __builtin_amdgcn_mbcnt_lo(~0u, z)); }
__device__ __forceinline__ float bperm_xor(float v, int lane, int mask) { return __builtin_bit_cast(float, __builtin_amdgcn_ds_bpermute((lane ^ mask) << 2, __builtin_bit_cast(int, v))); }
namespace pg8 {
#define PG8_LAS __attribute__((address_space(3)))
typedef unsigned short bf16_t;
typedef short bf16x8 __attribute__((ext_vector_type(8)));
typedef float f32x4 __attribute__((ext_vector_type(4)));
typedef unsigned u32x4 __attribute__((ext_vector_type(4)));
constexpr int BM = 256, BK = 64, HALF = 128, HTB = HALF * BK * 2  , STAGE_BYTES = 8 * HTB, NXCD = 8, WGM = 8;

__host__ __device__ __forceinline__ int lds_byte(int r, int c) { const int st = (r >> 4) * 2 + (c >> 5), rr = r & 15, cc = c & 31, ob = rr * 64 + cc * 2; return st * 1024 + (ob ^ (((ob >> 9) & 1) << 5)); }
__host__ __device__ __forceinline__ void stage_rc(int b, int& R, int& C) { const int st = b / 1024, sb = b % 1024, swz = sb ^ (((sb >> 9) & 1) << 5); R = (st >> 1) * 16 + swz / 64; C = (st & 1) * 32 + (swz % 64) / 2; }
__host__ __device__ __forceinline__ int perm32(int rho) { const int n = rho >> 4, i = rho & 15; return 8 * (i >> 2) + 4 * n + (i & 3); }

struct Unit { int pm, pn; };
struct Gemm { const bf16_t* A; const bf16_t* Bt; int M, N, K; };

struct StaticOrder {
    int nM, nN, nwg, G, c;
    __host__ __device__ void init(int M, int N, int G_, int c_) { nM = M / BM; nN = N / BM; nwg = nM * nN; G = G_; c = c_; }
    __host__ __device__ bool next(int i, Unit& u) const {
        const long L = (long)i * G + c; if (L >= nwg) return false;
        int wgid = (int)L; { const int q = nwg / NXCD, r = nwg % NXCD, xcd = wgid % NXCD, off = wgid / NXCD; wgid = (xcd < r ? xcd * (q + 1) : r * (q + 1) + (xcd - r) * q) + off; }
        const int nig = WGM * nN, gid = wgid / nig, fm = gid * WGM, gsz = (nM - fm) < WGM ? (nM - fm) : WGM;
        u.pm = fm + ((wgid % nig) % gsz); u.pn = (wgid % nig) / gsz; return true;
    }
    __device__ __forceinline__ void a_ready(const Unit&) const {}
    __device__ __forceinline__ void done(const Unit&) const {}
};

typedef float f32x2 __attribute__((ext_vector_type(2))); typedef __bf16 bf16x2v __attribute__((ext_vector_type(2)));
__device__ __forceinline__ unsigned cvt_pk_bf16(float lo, float hi) { f32x2 v = {lo, hi}; bf16x2v b = __builtin_convertvector(v, bf16x2v); return __builtin_bit_cast(unsigned, b); }
constexpr int SEQ_ = 8192;
__device__ __forceinline__ u32x4 pack8(const f32x4& a, const f32x4& b) { u32x4 w; w.x = cvt_pk_bf16(a[0], a[1]); w.y = cvt_pk_bf16(a[2], a[3]); w.z = cvt_pk_bf16(b[0], b[1]); w.w = cvt_pk_bf16(b[2], b[3]); return w; }
__device__ __forceinline__ float silu_mul(float g, float u) { return g * u * __builtin_amdgcn_rcpf(1.f + __builtin_amdgcn_exp2f(-1.4426950408889634f * g)); }
__device__ __forceinline__ void rope8(f32x4& a, f32x4& b, const f32x4 c4, const f32x4 s4) {
    const f32x4 a0 = a, b0 = b;
    a[0] = a0[0] * c4[0] - a0[1] * s4[0]; a[1] = a0[1] * c4[0] + a0[0] * s4[0];
    a[2] = a0[2] * c4[1] - a0[3] * s4[1]; a[3] = a0[3] * c4[1] + a0[2] * s4[1];
    b[0] = b0[0] * c4[2] - b0[1] * s4[2]; b[1] = b0[1] * c4[2] + b0[0] * s4[2];
    b[2] = b0[2] * c4[3] - b0[3] * s4[3]; b[3] = b0[3] * c4[3] + b0[2] * s4[3];
}
struct EpiStore {
    static constexpr bool PERM = true, AFTER_DRAIN = false;
    bf16_t* O; int ldc;
    __device__ __forceinline__ void operator()(const f32x4 (&acc)[2][2][4][2], const Unit& u, int wr, int wc, int fr, int fq) const {
        const int row0 = u.pm * BM + wr * 64 + fr, col0 = u.pn * BM + wc * 32 + 8 * fq;
#pragma unroll
        for (int ai = 0; ai < 2; ++ai)
#pragma unroll
            for (int m = 0; m < 4; ++m) { bf16_t* rowp = O + (size_t)(row0 + ai * HALF + m * 16) * ldc + col0;
#pragma unroll
                for (int bj = 0; bj < 2; ++bj) *(u32x4*)(rowp + bj * HALF) = pack8(acc[ai][bj][m][0], acc[ai][bj][m][1]); }
    }
};
struct EpiSwiGLU {
    static constexpr bool PERM = true, AFTER_DRAIN = false;
    bf16_t* O; int ldc; const float* rs;
    __device__ __forceinline__ void operator()(const f32x4 (&acc)[2][2][4][2], const Unit& u, int wr, int wc, int fr, int fq) const {
        const int row0 = u.pm * BM + wr * 64 + fr, col0 = u.pn * HALF + wc * 32 + 8 * fq;
#pragma unroll
        for (int ai = 0; ai < 2; ++ai)
#pragma unroll
            for (int m = 0; m < 4; ++m) { f32x4 r0, r1; const float r = rs[row0 + ai * HALF + m * 16];
#pragma unroll
                for (int e = 0; e < 4; ++e) { r0[e] = silu_mul(acc[ai][0][m][0][e] * r, acc[ai][1][m][0][e] * r); r1[e] = silu_mul(acc[ai][0][m][1][e] * r, acc[ai][1][m][1][e] * r); }
                *(u32x4*)(O + (size_t)(row0 + ai * HALF + m * 16) * ldc + col0) = pack8(r0, r1); }
    }
};
struct EpiWin {
    static constexpr bool PERM = true, AFTER_DRAIN = false;
    bf16_t *CQ, *CKV, *KR, *QB, *KB, *VB; float* stat; const float* rope; float qbscale; const float* rs;
    __device__ __forceinline__ void operator()(const f32x4 (&acc)[2][2][4][2], const Unit& u, int wr, int wc, int fr, int fq) const {
        const int row0 = u.pm * BM + wr * 64 + fr;
#pragma unroll
        for (int bj = 0; bj < 2; ++bj) {
            const int c32 = u.pn * BM + bj * HALF + wc * 32;
            if (c32 >= 1440) continue;
            if (c32 < 640) {
                const bool isq = c32 < 384; bf16_t* base = isq ? CQ : CKV; const int ld = isq ? 384 : 256, col = (isq ? c32 : c32 - 384) + 8 * fq;
#pragma unroll
                for (int ai = 0; ai < 2; ++ai)
#pragma unroll
                    for (int m = 0; m < 4; ++m) { const int row = row0 + ai * HALF + m * 16; const float r = rs[row]; const f32x4 a = acc[ai][bj][m][0] * r, b = acc[ai][bj][m][1] * r;
                        *(u32x4*)(base + (size_t)row * ld + col) = pack8(a, b);
                        float s = (a[0] * a[0] + a[1] * a[1]) + (a[2] * a[2] + a[3] * a[3]) + (b[0] * b[0] + b[1] * b[1]) + (b[2] * b[2] + b[3] * b[3]);
                        s += bperm_xor(s, fq * 16 + fr, 16); s += bperm_xor(s, fq * 16 + fr, 32);
                        if (fq == 0) stat[(size_t)row * 20 + (c32 >> 5)] = s; }
            } else if (c32 == 640) {
#pragma unroll
                for (int ai = 0; ai < 2; ++ai)
#pragma unroll
                    for (int m = 0; m < 4; ++m) { const int row = row0 + ai * HALF + m * 16, pos = row & (SEQ_ - 1); const float r = rs[row]; f32x4 a = acc[ai][bj][m][0] * r, b = acc[ai][bj][m][1] * r;
                        const f32x4 c4 = *(const f32x4*)(rope + (size_t)pos * 32 + 4 * fq), s4 = *(const f32x4*)(rope + (size_t)pos * 32 + 16 + 4 * fq);
                        rope8(a, b, c4, s4);
                        *(u32x4*)(KR + (size_t)row * 32 + 8 * fq) = pack8(a, b); }
            } else {
                bf16_t* base; int ld, col; float sc = 1.f;
                if (c32 < 1184) { base = QB; ld = 512; col = c32 - 672; sc = qbscale; } else if (c32 < 1312) { base = KB; ld = 128; col = c32 - 1184; } else { base = VB; ld = 128; col = c32 - 1312; }
                col += 8 * fq;
#pragma unroll
                for (int ai = 0; ai < 2; ++ai)
#pragma unroll
                    for (int m = 0; m < 4; ++m) { const int row = row0 + ai * HALF + m * 16; const float r = rs[row] * sc;
                        *(u32x4*)(base + (size_t)row * ld + col) = pack8(acc[ai][bj][m][0] * r, acc[ai][bj][m][1] * r); }
            }
        }
    }
};
struct EpiUq {
    static constexpr bool PERM = true, AFTER_DRAIN = false;
    bf16_t* Q; const float* stat; const float* rope; float qscale;
    __device__ __forceinline__ void operator()(const f32x4 (&acc)[2][2][4][2], const Unit& u, int wr, int wc, int fr, int fq) const {
        const int row0 = u.pm * BM + wr * 64 + fr;
#pragma unroll
        for (int ai = 0; ai < 2; ++ai)
#pragma unroll
            for (int m = 0; m < 4; ++m) { const int row = row0 + ai * HALF + m * 16, pos = row & (SEQ_ - 1);
                const f32x4* sp = (const f32x4*)(stat + (size_t)row * 20); const f32x4 s0 = sp[0], s1 = sp[1], s2 = sp[2];
                const float ssq = ((s0[0] + s0[1]) + (s0[2] + s0[3])) + ((s1[0] + s1[1]) + (s1[2] + s1[3])) + ((s2[0] + s2[1]) + (s2[2] + s2[3]));
                const float rs = __builtin_amdgcn_rsqf(ssq * (1.0f / 384.0f) + 1e-6f) * qscale;
#pragma unroll
                for (int bj = 0; bj < 2; ++bj) { const int c32 = u.pn * BM + bj * HALF + wc * 32; f32x4 a = acc[ai][bj][m][0] * rs, b = acc[ai][bj][m][1] * rs;
                    if ((c32 % 96) == 64) { const f32x4 c4 = *(const f32x4*)(rope + (size_t)pos * 32 + 4 * fq), s4 = *(const f32x4*)(rope + (size_t)pos * 32 + 16 + 4 * fq); rope8(a, b, c4, s4); }
                    *(u32x4*)(Q + (size_t)row * 768 + c32 + 8 * fq) = pack8(a, b); } }
    }
};
struct EpiUkv {
    static constexpr bool PERM = true, AFTER_DRAIN = false;
    bf16_t *KN, *V; const float* stat;
    __device__ __forceinline__ void operator()(const f32x4 (&acc)[2][2][4][2], const Unit& u, int wr, int wc, int fr, int fq) const {
        const int row0 = u.pm * BM + wr * 64 + fr; const int colt = u.pn * BM; bf16_t* base = colt < 512 ? KN : V; const int col0 = (colt & 511) + wc * 32 + 8 * fq;
#pragma unroll
        for (int ai = 0; ai < 2; ++ai)
#pragma unroll
            for (int m = 0; m < 4; ++m) { const int row = row0 + ai * HALF + m * 16;
                const f32x4* sp = (const f32x4*)(stat + (size_t)row * 20 + 12); const f32x4 s0 = sp[0], s1 = sp[1];
                const float ssq = ((s0[0] + s0[1]) + (s0[2] + s0[3])) + ((s1[0] + s1[1]) + (s1[2] + s1[3]));
                const float rs = __builtin_amdgcn_rsqf(ssq * (1.0f / 256.0f) + 1e-6f);
#pragma unroll
                for (int bj = 0; bj < 2; ++bj) *(u32x4*)(base + (size_t)row * 512 + col0 + bj * HALF) = pack8(acc[ai][bj][m][0] * rs, acc[ai][bj][m][1] * rs); }
    }
};
template <class Epi, class Sched, bool ALIGN_EPI = false, bool SP2 = false>
__device__ __forceinline__ void gemm_phase(PG8_LAS unsigned char* lds, const Gemm g, const Sched& S, const Epi& E, const int wv) {
    const int tid = opaque_tid(wv), wid = __builtin_amdgcn_readfirstlane(tid >> 6), lane = tid & 63, wr = wid >> 2, wc = wid & 3, fr = lane & 15, fq = lane >> 4;
    const int K = g.K, nt = K / BK;
    unsigned voffA[2], voffB[2];
#pragma unroll
    for (int i = 0; i < 2; ++i) { int R, C; stage_rc(tid * 16 + i * 8192, R, C); const int Rb = Epi::PERM ? ((R & ~31) + perm32(R & 31)) : R;
        voffA[i] = (unsigned)(R * K + C) * 2u; voffB[i] = (unsigned)(Rb * K + C) * 2u; }
    const size_t kstep = (size_t)(BK * 2);
    const size_t hstep = (size_t)HALF * K * 2;
    const size_t tstep = 2 * hstep;
    const unsigned ldsw = (unsigned)wid * 1024u;
    const int aoff = lds_byte(wr * 64 + fr, fq * 8), boff = lds_byte(wc * 32 + fr, fq * 8);
#define PG8_SA(b, h) (((b) * 2 + (h)) * HTB)
#define PG8_SB(b, h) ((4 + (b) * 2 + (h)) * HTB)
#define PG8_STAGE(bufoff, gbase, voff) do { _Pragma("unroll") for (int _i = 0; _i < 2; ++_i) \
        __builtin_amdgcn_global_load_lds((const unsigned*)((const char*)(gbase) + (voff)[_i]), (PG8_LAS unsigned*)(lds + (bufoff) + ldsw + _i * 8192), 16, 0, 0); } while (0)
#define PG8_LDA(dst, b, h) do { _Pragma("unroll") for (int m = 0; m < 4; ++m) _Pragma("unroll") for (int k = 0; k < 2; ++k) dst[m][k] = *(const PG8_LAS bf16x8*)(lds + PG8_SA(b, h) + aoff + m * 2048 + k * 1024); } while (0)
#define PG8_LDB(dst, b, h) do { _Pragma("unroll") for (int n = 0; n < 2; ++n) _Pragma("unroll") for (int k = 0; k < 2; ++k) dst[n][k] = *(const PG8_LAS bf16x8*)(lds + PG8_SB(b, h) + boff + n * 2048 + k * 1024); } while (0)
#define PG8_MMA(ai, bj, At, Bt) do { __builtin_amdgcn_s_setprio(1); _Pragma("unroll") for (int m = 0; m < 4; ++m) _Pragma("unroll") for (int n = 0; n < 2; ++n) _Pragma("unroll") for (int k = 0; k < 2; ++k) \
        acc[ai][bj][m][n] = __builtin_amdgcn_mfma_f32_16x16x32_bf16(Bt[n][k], At[m][k], acc[ai][bj][m][n], 0, 0, 0); __builtin_amdgcn_s_setprio(0); } while (0)
#define PG8_WAIT_V(n) asm volatile("s_waitcnt vmcnt(" #n ")" ::: "memory")
#define PG8_WAIT_L(n) asm volatile("s_waitcnt lgkmcnt(" #n ")" ::: "memory")
#define PG8_BAR __builtin_amdgcn_s_barrier()
#define PG8_SCHED __builtin_amdgcn_sched_barrier(0)
    Unit cur, nxt; int ui = 0;
    if (!S.next(0, cur)) return;
    f32x4 acc[2][2][4][2];
#pragma unroll
    for (int a = 0; a < 2; ++a)
#pragma unroll
        for (int b = 0; b < 2; ++b)
#pragma unroll
            for (int m = 0; m < 4; ++m)
#pragma unroll
                for (int n = 0; n < 2; ++n) acc[a][b][m][n] = (f32x4){0.f, 0.f, 0.f, 0.f};
    bf16x8 At[4][2], B0[2][2], B1[2][2];
    const char* cA = (const char*)g.A + (size_t)cur.pm * tstep; const char* cB = (const char*)g.Bt + (size_t)cur.pn * tstep;
    S.a_ready(cur);
    if constexpr (SP2) {
        PG8_STAGE(PG8_SB(0, 0), cB, voffB); PG8_STAGE(PG8_SB(0, 1), cB + hstep, voffB); PG8_STAGE(PG8_SA(0, 0), cA, voffA); PG8_STAGE(PG8_SA(0, 1), cA + hstep, voffA);
        if (wr == 1) PG8_BAR;
        PG8_WAIT_V(2); PG8_BAR;
        PG8_STAGE(PG8_SB(1, 0), cB + kstep, voffB); PG8_STAGE(PG8_SA(1, 0), cA + kstep, voffA); PG8_STAGE(PG8_SB(1, 1), cB + hstep + kstep, voffB);
        PG8_WAIT_V(6); PG8_BAR;
    } else {
        PG8_STAGE(PG8_SB(0, 0), cB, voffB); PG8_STAGE(PG8_SA(0, 0), cA, voffA); PG8_STAGE(PG8_SB(0, 1), cB + hstep, voffB); PG8_STAGE(PG8_SA(0, 1), cA + hstep, voffA);
        if (wr == 1) PG8_BAR;
        PG8_WAIT_V(4); PG8_BAR;
        PG8_STAGE(PG8_SB(1, 0), cB + kstep, voffB); PG8_STAGE(PG8_SA(1, 0), cA + kstep, voffA); PG8_STAGE(PG8_SB(1, 1), cB + hstep + kstep, voffB);
        PG8_WAIT_V(6); PG8_BAR;
    }
    for (;;) {
        const bool has_next = S.next(ui + 1, nxt);
        const char* nA = has_next ? (const char*)g.A + (size_t)nxt.pm * tstep : cA; const char* nB = has_next ? (const char*)g.Bt + (size_t)nxt.pn * tstep : cB;
        for (int t = 0; t < nt; t += 2) {
            const bool last = (t == nt - 2);
            const char* a1 = cA + (size_t)(t + 1) * kstep;
            const char* a2 = last ? nA : cA + (size_t)(t + 2) * kstep; const char* b2 = last ? nB : cB + (size_t)(t + 2) * kstep;
            const char* a3 = a2 + kstep; const char* b3 = b2 + kstep;
            if (last && has_next) S.a_ready(nxt);
            if constexpr (SP2) {
            PG8_LDB(B0, 0, 0); PG8_LDB(B1, 0, 1); PG8_SCHED; PG8_LDA(At, 0, 0); PG8_STAGE(PG8_SA(1, 1), a1 + hstep, voffA);
            PG8_WAIT_V(8); PG8_WAIT_L(0); PG8_BAR; PG8_MMA(0, 0, At, B0); PG8_MMA(0, 1, At, B1); PG8_BAR; PG8_SCHED;
            PG8_LDA(At, 0, 1); PG8_STAGE(PG8_SB(0, 0), b2, voffB); PG8_STAGE(PG8_SB(0, 1), b2 + hstep, voffB); PG8_STAGE(PG8_SA(0, 0), a2, voffA);
            PG8_WAIT_V(8); PG8_WAIT_L(0); PG8_BAR; PG8_MMA(1, 0, At, B0); PG8_MMA(1, 1, At, B1); PG8_BAR; PG8_SCHED;
            PG8_LDB(B0, 1, 0); PG8_LDB(B1, 1, 1); PG8_SCHED; PG8_LDA(At, 1, 0); PG8_STAGE(PG8_SA(0, 1), a2 + hstep, voffA);
            PG8_WAIT_V(8); PG8_WAIT_L(0); PG8_BAR; PG8_MMA(0, 0, At, B0); PG8_MMA(0, 1, At, B1); PG8_BAR; PG8_SCHED;
            PG8_LDA(At, 1, 1); PG8_STAGE(PG8_SB(1, 0), b3, voffB); PG8_STAGE(PG8_SB(1, 1), b3 + hstep, voffB); PG8_STAGE(PG8_SA(1, 0), a3, voffA);
            PG8_WAIT_V(8); PG8_WAIT_L(0); PG8_BAR; PG8_MMA(1, 0, At, B0); PG8_MMA(1, 1, At, B1); PG8_BAR; PG8_SCHED;
            } else {
            PG8_LDB(B0, 0, 0); PG8_SCHED; PG8_LDA(At, 0, 0); PG8_STAGE(PG8_SA(1, 1), a1 + hstep, voffA);
            PG8_WAIT_L(8); PG8_BAR; PG8_WAIT_L(0); PG8_MMA(0, 0, At, B0); PG8_BAR; PG8_SCHED;
            PG8_LDB(B1, 0, 1); PG8_STAGE(PG8_SB(0, 0), b2, voffB);
            PG8_BAR; PG8_WAIT_L(0); PG8_MMA(0, 1, At, B1); PG8_BAR;
            PG8_LDA(At, 0, 1); PG8_STAGE(PG8_SA(0, 0), a2, voffA);
            PG8_BAR; PG8_WAIT_L(0); PG8_MMA(1, 0, At, B0); PG8_BAR; PG8_SCHED;
            PG8_STAGE(PG8_SB(0, 1), b2 + hstep, voffB);
            PG8_WAIT_V(6); PG8_BAR; PG8_MMA(1, 1, At, B1); PG8_BAR;
            PG8_LDB(B0, 1, 0); PG8_SCHED; PG8_LDA(At, 1, 0); PG8_STAGE(PG8_SA(0, 1), a2 + hstep, voffA);
            PG8_WAIT_L(8); PG8_BAR; PG8_WAIT_L(0); PG8_MMA(0, 0, At, B0); PG8_BAR; PG8_SCHED;
            PG8_LDB(B1, 1, 1); PG8_STAGE(PG8_SB(1, 0), b3, voffB);
            PG8_BAR; PG8_WAIT_L(0); PG8_MMA(0, 1, At, B1); PG8_BAR;
            PG8_LDA(At, 1, 1); PG8_STAGE(PG8_SA(1, 0), a3, voffA);
            PG8_BAR; PG8_WAIT_L(0); PG8_MMA(1, 0, At, B0); PG8_BAR; PG8_SCHED;
            PG8_STAGE(PG8_SB(1, 1), b3 + hstep, voffB);
            PG8_WAIT_V(6); PG8_BAR; PG8_MMA(1, 1, At, B1); PG8_BAR;
            }
        }
        if constexpr (ALIGN_EPI) { if (wr == 0) PG8_BAR; }
        if constexpr (!Epi::AFTER_DRAIN) { E(acc, cur, wr, wc, fr, fq); S.done(cur); }
        if (!has_next) break;
#pragma unroll
        for (int a = 0; a < 2; ++a)
#pragma unroll
            for (int b = 0; b < 2; ++b)
#pragma unroll
                for (int m = 0; m < 4; ++m)
#pragma unroll
                    for (int n = 0; n < 2; ++n) acc[a][b][m][n] = (f32x4){0.f, 0.f, 0.f, 0.f};
        cur = nxt; cA = nA; cB = nB; ++ui;
        if constexpr (ALIGN_EPI) { if (wr == 1) PG8_BAR; }
    }
    PG8_WAIT_V(0);
    if constexpr (!ALIGN_EPI) { if (wr == 0) PG8_BAR; }
    PG8_BAR;
    if constexpr (Epi::AFTER_DRAIN) { E.fused(acc, cur, wr, wc, fr, fq, lds, wid, lane); S.done(cur); }
#undef PG8_SA
#undef PG8_SB
#undef PG8_STAGE
#undef PG8_LDA
#undef PG8_LDB
#undef PG8_MMA
#undef PG8_WAIT_V
#undef PG8_WAIT_L
#undef PG8_BAR
#undef PG8_SCHED
}
}
#define LAS __attribute__((address_space(3)))
typedef unsigned short bf16;
typedef short bf16x8 __attribute__((ext_vector_type(8)));
typedef float f32x4 __attribute__((ext_vector_type(4)));
typedef float f32x16 __attribute__((ext_vector_type(16)));
typedef unsigned u32x4 __attribute__((ext_vector_type(4)));
typedef unsigned u32x2 __attribute__((ext_vector_type(2)));

constexpr int BATCH = 8, SEQ = 8192, DM = 1024, MTOK = BATCH * SEQ, FF = 2816, DEPTH = 2;
constexpr int QRANK = 384, KVRANK = 256, INCOLS = 1440, INPAD = 1536;
constexpr float EPS = 1e-6f, LOG2E = 1.4426950408889634f;
constexpr float QSCALE_A = 0.10206207261596575f * LOG2E;
constexpr float QSCALE_B = 0.125f * LOG2E;
constexpr int NWAVES = 8, NTHREADS = 512;
constexpr int LDS_BYTES = 147456;

constexpr size_t MiB = 1u << 20;
constexpr size_t CTL_ZERO_BYTES = 64 * 1024; constexpr int CW_GRP = 8192, CW_XM = 8704;
constexpr size_t WS_ROPE = 1 * MiB, WS_BTAB = 2 * MiB, WS_RS = 2 * MiB + 256 * 1024;
constexpr size_t WS_W = 4 * MiB, WL_BYTES = 40 * MiB;
constexpr size_t WO_GU1 = 0, WO_D1 = 11 * MiB, WO_GU2 = 16 * MiB + MiB / 2, WO_D2 = 27 * MiB + MiB / 2, WO_WIN = 33 * MiB, WO_UQ = 36 * MiB, WO_UKV = 37 * MiB, WO_OUT = 38 * MiB;
constexpr size_t WS_Y = 212 * MiB, WS_BIG = 340 * MiB;
constexpr size_t SLICE = 67 * MiB;
constexpr size_t OFF_ACT = 0;
constexpr size_t OFF_CQ = 0, OFF_CKV = 6 * MiB, OFF_KR = 10 * MiB, OFF_QB = 11 * MiB, OFF_KB = 19 * MiB, OFF_VB = 21 * MiB, OFF_Q = 23 * MiB, OFF_KN = 35 * MiB, OFF_V = 43 * MiB, OFF_O = 51 * MiB;
constexpr size_t WS_STAT = WS_BIG + 8 * SLICE, WS_XB = WS_STAT + 6 * MiB, WS_END = WS_XB + 128 * MiB;
#define GB(ws, grp, OFF, LD) ((ws) + WS_BIG + (size_t)(grp) * (SLICE - (size_t)SEQ * (LD) * 2) + (OFF))

__device__ __forceinline__ unsigned f2bf(float f) { unsigned u = __builtin_bit_cast(unsigned, f); return (u + 0x7fffu + ((u >> 16) & 1u)) >> 16; }
__device__ __forceinline__ unsigned pk2(float lo, float hi) { return f2bf(lo) | (f2bf(hi) << 16); }
__device__ __forceinline__ float bf2f(unsigned h) { return __builtin_bit_cast(float, h << 16); }
__device__ __forceinline__ float wave_sum(float v, int lane) {
#pragma unroll
    for (int o = 1; o < 64; o <<= 1) v += bperm_xor(v, lane, o);
    return v;
}

__device__ __forceinline__ int map_col(int mat, int r, const float* W0, const float* W1, const float*& src) {
    src = W0;
    switch (mat) {
    case 0: { const int t = r >> 8, w = r & 255; if (w >= 128) src = W1; return t * 128 + (w & 127); }
    case 2: { if (r >= INCOLS) return -1; if (r >= 640 && r < 672) { const int idx = r - 640; return 640 + (idx >> 1) + 16 * (idx & 1); } return r; }
    case 3: { const int h = r / 96, w = r % 96; if (w < 64) return h * 96 + w; const int idx = w - 64; return h * 96 + 64 + (idx >> 1) + 16 * (idx & 1); }
    case 4: { if (r < 512) return (r >> 6) * 128 + (r & 63); const int r2 = r - 512; return (r2 >> 6) * 128 + 64 + (r2 & 63); }
    default: return r;
    }
}
__device__ __forceinline__ void tr_item(int mat, const float* W0, const float* W1, int N, int K, int NP, const float* gk, bf16* WT, int item, LAS float* scr, int lane) {
    const int nblk = NP / 32, kb = item / nblk, nb = item % nblk, k0 = 64 * kb, n0 = 32 * nb;
    const float* src; const int col = map_col(mat, n0 + (lane & 31), W0, W1, src);
#pragma unroll 8
    for (int i = 0; i < 32; ++i) { const int kk = 2 * i + (lane >> 5); float v = 0.f; if (col >= 0) v = src[(size_t)(k0 + kk) * N + col]; if (gk) v *= gk[k0 + kk]; scr[kk * 33 + (lane & 31)] = v; }
    asm volatile("s_waitcnt lgkmcnt(0)" ::: "memory");
    const int c = lane & 7;
#pragma unroll
    for (int j = 0; j < 4; ++j) { const int n = (lane >> 3) + 8 * j; const LAS float* s = scr + (8 * c) * 33 + n;
        u32x4 o; o.x = pk2(s[0 * 33], s[1 * 33]); o.y = pk2(s[2 * 33], s[3 * 33]); o.z = pk2(s[4 * 33], s[5 * 33]); o.w = pk2(s[6 * 33], s[7 * 33]);
        *(u32x4*)(WT + (size_t)(n0 + n) * K + k0 + 8 * c) = o; }
    asm volatile("s_waitcnt lgkmcnt(0)" ::: "memory");
}

struct Args { const float* in[21]; float* out; unsigned char* ws; int pad0, pad1; };
typedef const Args __attribute__((address_space(4)))* ArgP;

__device__ __forceinline__ void row_to_bf16_rs(const float* xrow, bf16* orow, float* rs, int lane) {
    const f32x4* xr = (const f32x4*)xrow + lane; f32x4 v[4]; float s = 0.f;
#pragma unroll
    for (int j = 0; j < 4; ++j) { v[j] = __builtin_nontemporal_load(xr + 64 * j); s += (v[j][0] * v[j][0] + v[j][1] * v[j][1]) + (v[j][2] * v[j][2] + v[j][3] * v[j][3]); }
    const float rstd = __builtin_amdgcn_rsqf(wave_sum(s, lane) * (1.f / DM) + EPS);
#pragma unroll
    for (int j = 0; j < 4; ++j) { u32x2 o; o.x = pk2(v[j][0], v[j][1]); o.y = pk2(v[j][2], v[j][3]); ((u32x2*)orow)[lane + 64 * j] = o; }
    if (lane == 0) *rs = rstd;
}

__device__ __forceinline__ int t5_bucket(int rel) {
    const int n = rel < 0 ? -rel : rel; int b = rel > 0 ? 16 : 0;
    const float nf = (float)(n > 1 ? n : 1);
    int large = 8 + (int)(logf(nf / 8.0f) / 2.772588722239781f * 8.0f);
    large = large < 15 ? large : 15;
    return b + (n < 8 ? n : large);
}

__device__ __forceinline__ void prologue(ArgP a, LAS unsigned char* lds, int gw, int NGW, int lane, int wave) {
    LAS float* scr = (LAS float*)(lds + wave * 16384);
    unsigned char* ws = a->ws;
    constexpr int I_GU = 16 * 176, I_D = 44 * 32, I_WIN = 16 * 48, I_UQ = 6 * 24, I_UKV = 4 * 32, I_OUT = 16 * 32;
    constexpr int PER_L = 2 * I_GU + 2 * I_D + I_WIN + I_UQ + I_UKV + I_OUT;
    for (int it = gw; it < DEPTH * PER_L; it += NGW) {
        const int L = it / PER_L; int r = it % PER_L; unsigned char* wl = ws + WS_W + (size_t)L * WL_BYTES;
        if (r < I_GU) { tr_item(0, a->in[3] + (size_t)L * DM * FF, a->in[4] + (size_t)L * DM * FF, FF, DM, 2 * FF, a->in[2] + L * DM, (bf16*)(wl + WO_GU1), r, scr, lane); continue; } r -= I_GU;
        if (r < I_D) { tr_item(1, a->in[5] + (size_t)L * FF * DM, nullptr, DM, FF, DM, nullptr, (bf16*)(wl + WO_D1), r, scr, lane); continue; } r -= I_D;
        if (r < I_GU) { tr_item(0, a->in[17] + (size_t)L * DM * FF, a->in[18] + (size_t)L * DM * FF, FF, DM, 2 * FF, a->in[16] + L * DM, (bf16*)(wl + WO_GU2), r, scr, lane); continue; } r -= I_GU;
        if (r < I_D) { tr_item(1, a->in[19] + (size_t)L * FF * DM, nullptr, DM, FF, DM, nullptr, (bf16*)(wl + WO_D2), r, scr, lane); continue; } r -= I_D;
        if (r < I_WIN) { tr_item(2, a->in[8] + (size_t)L * DM * INCOLS, nullptr, INCOLS, DM, INPAD, a->in[7] + L * DM, (bf16*)(wl + WO_WIN), r, scr, lane); continue; } r -= I_WIN;
        if (r < I_UQ) { tr_item(3, a->in[10] + (size_t)L * QRANK * 768, nullptr, 768, QRANK, 768, a->in[9] + L * QRANK, (bf16*)(wl + WO_UQ), r, scr, lane); continue; } r -= I_UQ;
        if (r < I_UKV) { tr_item(4, a->in[12] + (size_t)L * KVRANK * 1024, nullptr, 1024, KVRANK, 1024, a->in[11] + L * KVRANK, (bf16*)(wl + WO_UKV), r, scr, lane); continue; } r -= I_UKV;
        tr_item(1, a->in[14] + (size_t)L * DM * DM, nullptr, DM, DM, DM, nullptr, (bf16*)(wl + WO_OUT), r, scr, lane);
    }
    float* rope = (float*)(ws + WS_ROPE);
    for (int e = gw * 64 + lane; e < SEQ * 16; e += NGW * 64) {
        const int pos = e >> 4, i = e & 15; const int i4 = i & 3, i16 = i >> 2;
        double inv = i4 == 0 ? 1.0 : i4 == 1 ? 0.5623413251903491 : i4 == 2 ? 0.31622776601683794 : 0.1778279410038923;
        inv *= i16 == 0 ? 1.0 : i16 == 1 ? 0.1 : i16 == 2 ? 0.01 : 0.001;
        const double rev = (double)pos * inv * 0.15915494309189535; const float fr = (float)(rev - floor(rev));
        rope[pos * 32 + i] = __builtin_amdgcn_cosf(fr); rope[pos * 32 + 16 + i] = __builtin_amdgcn_sinf(fr);
    }
    float* bt = (float*)(ws + WS_BTAB);
    for (int e = gw * 64 + lane; e < 8 * 260; e += NGW * 64) { const int h = e / 260, idx = e % 260; bt[e] = (idx >= 1 && idx <= 257) ? a->in[1][t5_bucket(idx - 129) * 8 + h] * LOG2E : -1e30f; }
    for (int m0 = gw; m0 < MTOK; m0 += 2 * NGW) {
        f32x4 v[2][4]; float s[2] = {0.f, 0.f};
#pragma unroll
        for (int q = 0; q < 2; ++q) { const f32x4* xr = (const f32x4*)(a->in[0] + (size_t)(m0 + q * NGW) * DM) + lane;
#pragma unroll
            for (int j = 0; j < 4; ++j) v[q][j] = __builtin_nontemporal_load(xr + 64 * j); }
#pragma unroll
        for (int q = 0; q < 2; ++q) { const int m = m0 + q * NGW;
#pragma unroll
            for (int j = 0; j < 4; ++j) { s[q] += (v[q][j][0] * v[q][j][0] + v[q][j][1] * v[q][j][1]) + (v[q][j][2] * v[q][j][2] + v[q][j][3] * v[q][j][3]);
                u32x2 o; o.x = pk2(v[q][j][0], v[q][j][1]); o.y = pk2(v[q][j][2], v[q][j][3]); ((u32x2*)((bf16*)(ws + WS_XB) + (size_t)m * DM))[lane + 64 * j] = o; } }
        const float r0 = __builtin_amdgcn_rsqf(wave_sum(s[0], lane) * (1.f / DM) + EPS), r1 = __builtin_amdgcn_rsqf(wave_sum(s[1], lane) * (1.f / DM) + EPS);
        if (lane == 0) { ((float*)(ws + WS_RS))[m0] = r0; ((float*)(ws + WS_RS))[m0 + NGW] = r1; }
    }
}

template <bool XIN_BF, bool XOUT_BF>
__device__ __forceinline__ void norm_pass(const bf16* Y, const void* xsrc_, void* xdst_, const float* gpost, float w, float* rs, int mstart, int mend, int mstep, int lane) {
    f32x4 gp[4];
#pragma unroll
    for (int j = 0; j < 4; ++j) gp[j] = ((const f32x4*)gpost)[lane + 64 * j] * w;
    for (int m0 = mstart; m0 < mend; m0 += 2 * mstep) {
        f32x4 y[2][4], x[2][4]; float s[2] = {0.f, 0.f};
#pragma unroll
        for (int q = 0; q < 2; ++q) { const int m = m0 + q * mstep; const u32x2* yr = (const u32x2*)(Y + (size_t)m * DM) + lane;
#pragma unroll
            for (int j = 0; j < 4; ++j) { const u32x2 t = __builtin_nontemporal_load(yr + 64 * j);
                if (XIN_BF) { const u32x2 tx = ((const u32x2*)((const bf16*)xsrc_ + (size_t)m * DM))[lane + 64 * j]; x[q][j][0] = bf2f(tx.x & 0xffffu); x[q][j][1] = bf2f(tx.x >> 16); x[q][j][2] = bf2f(tx.y & 0xffffu); x[q][j][3] = bf2f(tx.y >> 16); }
                else x[q][j] = __builtin_nontemporal_load((const f32x4*)((const float*)xsrc_ + (size_t)m * DM) + lane + 64 * j);
                y[q][j][0] = bf2f(t.x & 0xffffu); y[q][j][1] = bf2f(t.x >> 16); y[q][j][2] = bf2f(t.y & 0xffffu); y[q][j][3] = bf2f(t.y >> 16); } }
#pragma unroll
        for (int q = 0; q < 2; ++q)
#pragma unroll
            for (int j = 0; j < 4; ++j) s[q] += (y[q][j][0] * y[q][j][0] + y[q][j][1] * y[q][j][1]) + (y[q][j][2] * y[q][j][2] + y[q][j][3] * y[q][j][3]);
        float rstd[2]; rstd[0] = __builtin_amdgcn_rsqf(wave_sum(s[0], lane) * (1.f / DM) + EPS); rstd[1] = __builtin_amdgcn_rsqf(wave_sum(s[1], lane) * (1.f / DM) + EPS);
        float s2[2] = {0.f, 0.f};
#pragma unroll
        for (int q = 0; q < 2; ++q) { const int m = m0 + q * mstep;
#pragma unroll
            for (int j = 0; j < 4; ++j) { x[q][j] = x[q][j] + y[q][j] * gp[j] * rstd[q];
                if (XOUT_BF) { u32x2 o; o.x = pk2(x[q][j][0], x[q][j][1]); o.y = pk2(x[q][j][2], x[q][j][3]); ((u32x2*)((bf16*)xdst_ + (size_t)m * DM))[lane + 64 * j] = o; }
                else __builtin_nontemporal_store(x[q][j], (f32x4*)((float*)xdst_ + (size_t)m * DM) + lane + 64 * j);
                s2[q] += (x[q][j][0] * x[q][j][0] + x[q][j][1] * x[q][j][1]) + (x[q][j][2] * x[q][j][2] + x[q][j][3] * x[q][j][3]); } }
        if (rs) { const float r0 = __builtin_amdgcn_rsqf(wave_sum(s2[0], lane) * (1.f / DM) + EPS), r1 = __builtin_amdgcn_rsqf(wave_sum(s2[1], lane) * (1.f / DM) + EPS);
            if (lane == 0) { rs[m0] = r0; rs[m0 + mstep] = r1; } }
    }
}

constexpr int KROWB = 208, VROWB = 192, ATT_KBYTES = 64 * KROWB, ATT_VBYTES = 64 * VROWB, ATT_VBASE = 2 * ATT_KBYTES, ATT_BT_OFF = ATT_VBASE + 2 * ATT_VBYTES + 1024, ATT_OST_OFF = 61440;
struct AttnT { const bf16* Q; int ldq; const bf16* K; int ldk; const bf16* KR; const bf16* V; int ldv; bf16* O; };
typedef short v4i16_t __attribute__((ext_vector_type(4)));
__device__ __forceinline__ float hswap_max(float v) { auto rr = __builtin_amdgcn_permlane32_swap(__float_as_uint(v), __float_as_uint(v), false, false); return fmaxf(__uint_as_float(rr[0]), __uint_as_float(rr[1])); }
__device__ __forceinline__ float hswap_sum(float v) { auto rr = __builtin_amdgcn_permlane32_swap(__float_as_uint(v), __float_as_uint(v), false, false); return __uint_as_float(rr[0]) + __uint_as_float(rr[1]); }
typedef float f32x2_t __attribute__((ext_vector_type(2))); typedef __bf16 bf16x2_t __attribute__((ext_vector_type(2)));
__device__ __forceinline__ unsigned cvtpk(float lo, float hi) { f32x2_t v = {lo, hi}; bf16x2_t b = __builtin_convertvector(v, bf16x2_t); return __builtin_bit_cast(unsigned, b); }
__device__ __forceinline__ v4i16_t vtr(const LAS unsigned char* p) { return __builtin_amdgcn_ds_read_tr16_b64_v4i16((LAS v4i16_t*)p); }
#define ATT_SBAR() __builtin_amdgcn_sched_barrier(0)

template <int MODE>
__device__ __forceinline__ void attn_unit(LAS unsigned char* lds, const AttnT& T, int b, int q0, int qcol, int kcol, int vcol, int ocol, float sink_l2, const LAS float* btab, const int wv) {
    constexpr int KS = MODE == 0 ? 6 : 4;
    const int tid = opaque_tid(wv), lane = tid & 63, l32 = lane & 31, hi = lane >> 5; const int wid = __builtin_amdgcn_readfirstlane(tid >> 6);
    const size_t rowbase = (size_t)b * SEQ;
    if (wid >= 4) __builtin_amdgcn_s_setprio(1);
    bf16x8 qr[KS];
    { const bf16* qrow = T.Q + (rowbase + q0 + wid * 32 + l32) * T.ldq + qcol + hi * 8;
#pragma unroll
      for (int ks = 0; ks < KS; ++ks) qr[ks] = *(const bf16x8*)(qrow + ks * 16); }
    int kvs, NT;
    if (MODE == 0) { kvs = 0; NT = SEQ / 64; } else { const int tlo = q0 == 0 ? 2 : 0, thi = (q0 + 384 > SEQ) ? 6 : 8; kvs = q0 - 128 + 64 * tlo; NT = thi - tlo; }
    const int srow = tid >> 3, sc = tid & 7, rr = tid >> 2, rc = tid & 3; const bool rrole = MODE == 0 && tid < 256;
    const bf16* vsrc = T.V + (rowbase + kvs + srow) * T.ldv + vcol + 8 * sc;
    const bf16* ksrc = T.K + (rowbase + kvs + srow) * T.ldk + kcol + 8 * sc;
    const bf16* rsrc = MODE == 0 ? T.KR + (rowbase + kvs + rr) * 32 + 8 * rc : nullptr;
    u32x4 st0, st1, st2;
#define ATT_LOADK(t) do { st0 = *(const u32x4*)(ksrc + (size_t)(t) * 64 * T.ldk); if (rrole) st2 = *(const u32x4*)(rsrc + (size_t)(t) * 64 * 32); } while (0)
#define ATT_LOADV(t) do { st1 = *(const u32x4*)(vsrc + (size_t)(t) * 64 * T.ldv); } while (0)
#define ATT_STOREK(slot) do { LAS unsigned char* kb_ = lds + (slot) * ATT_KBYTES; *(LAS u32x4*)(kb_ + srow * KROWB + 16 * sc) = st0; if (rrole) *(LAS u32x4*)(kb_ + rr * KROWB + 128 + 16 * rc) = st2; } while (0)
#define ATT_STOREV(slot) do { *(LAS u32x4*)(lds + ATT_VBASE + (slot) * ATT_VBYTES + srow * VROWB + 16 * sc) = st1; } while (0)
    const int pim = (l32 & 0x13) | ((l32 & 4) << 1) | ((l32 & 8) >> 1);
    const int koff = pim * KROWB + hi * 16;
    const int voff = ATT_VBASE + (8 * hi + ((lane & 15) >> 2)) * VROWB + (16 * ((lane >> 4) & 1) + 4 * (lane & 3)) * 2;
    float mrun = MODE == 1 ? sink_l2 : 0.f, lsum = (MODE == 1 && hi == 0) ? 1.f : 0.f;
    f32x16 o0 = {}, o1 = {}, pA0, pA1, pB0, pB1, negm;
    const int qpos = q0 + wid * 32 + l32;
    bf16x8 kf[2 * KS]; v4i16_t vl[8], vh[8]; u32x4 w0, w1, w2, w3;
#define ATT_KREAD(slot) do { const LAS unsigned char* kb_ = lds + (slot) * ATT_KBYTES; \
        _Pragma("unroll") for (int ks = 0; ks < KS; ++ks) { kf[2 * ks] = *(const LAS bf16x8*)(kb_ + koff + ks * 32); kf[2 * ks + 1] = *(const LAS bf16x8*)(kb_ + koff + 32 * KROWB + ks * 32); } } while (0)
#define ATT_KRD(slot, ks) do { const LAS unsigned char* kb_ = lds + (slot) * ATT_KBYTES; kf[2 * (ks)] = *(const LAS bf16x8*)(kb_ + koff + (ks) * 32); kf[2 * (ks) + 1] = *(const LAS bf16x8*)(kb_ + koff + 32 * KROWB + (ks) * 32); } while (0)
#define ATT_VREAD(i, vb_) do { const LAS unsigned char* vp_ = (vb_) + voff + ((i) >> 1) * 16 * VROWB + ((i) & 1) * 64; vl[i] = vtr(vp_); vh[i] = vtr(vp_ + 4 * VROWB); } while (0)
#define ATT_VF(i) (bf16x8){vl[i][0], vl[i][1], vl[i][2], vl[i][3], vh[i][0], vh[i][1], vh[i][2], vh[i][3]}
#define ATT_MM(acc, a_, b_) acc = __builtin_amdgcn_mfma_f32_32x32x16_bf16(a_, b_, acc, 0, 0, 0)
#define ATT_EP(P, r, W, wi) do { P[r] = __builtin_amdgcn_exp2f(P[r]); P[(r) + 1] = __builtin_amdgcn_exp2f(P[(r) + 1]); lacc += P[r]; lacc += P[(r) + 1]; W[wi] = cvtpk(P[r], P[(r) + 1]); } while (0)
#define ATT_SM4(P0, P1, r, kvb_) do { if (MODE == 1) { _Pragma("unroll") for (int r_ = (r); r_ < (r) + 2; ++r_) { \
                const int j0 = (kvb_) + 16 * (r_ >> 3) + 8 * hi + (r_ & 7) - qpos + 129, j1 = j0 + 32; \
                const int i0 = j0 < 0 ? 0 : (j0 > 258 ? 258 : j0), i1 = j1 < 0 ? 0 : (j1 > 258 ? 258 : j1); \
                P0[r_] += btab[i0]; P1[r_] += btab[i1]; } } } while (0)
#define ATT_DECIDE(P0, P1, lacc_) do { const float lt_ = hswap_max(lacc_); \
        if (__any(lt_ > 65536.f)) { const float dl = lt_ > 65536.f ? (float)__builtin_amdgcn_frexp_expf(lt_) : 0.f, al = __builtin_amdgcn_exp2f(-dl); mrun += dl; lsum *= al; \
            _Pragma("unroll") for (int r = 0; r < 16; ++r) { o0[r] *= al; o1[r] *= al; P0[r] -= dl; P1[r] -= dl; negm[r] = -mrun; } } } while (0)
#define ATT_STEP(PC0, PC1, PN0, PN1, tt) do { \
        const int kslot_ = (tt) & 1; const bool kmore_ = (tt) + 2 < NT; const LAS unsigned char* vb_ = lds + ((tt) & 1) * ATT_VBYTES; const int kvn_ = kvs + 64 * ((tt) + 1); \
        if ((tt) + 3 < NT) ATT_LOADK((tt) + 3); ATT_LOADV((tt) + 1); \
        float lacc = 0.f; ATT_SBAR(); \
        PN0 = __builtin_amdgcn_mfma_f32_32x32x16_bf16(kf[0], qr[0], negm, 0, 0, 0); ATT_EP(PC0, 0, w0, 0); ATT_EP(PC0, 2, w0, 1); ATT_SBAR(); \
        PN1 = __builtin_amdgcn_mfma_f32_32x32x16_bf16(kf[1], qr[0], negm, 0, 0, 0); ATT_EP(PC0, 4, w0, 2); ATT_EP(PC0, 6, w0, 3); ATT_SBAR(); \
        ATT_MM(PN0, kf[2], qr[1]); ATT_EP(PC0, 8, w1, 0); ATT_EP(PC0, 10, w1, 1); ATT_SBAR(); \
        ATT_MM(PN1, kf[3], qr[1]); ATT_EP(PC0, 12, w1, 2); ATT_EP(PC0, 14, w1, 3); ATT_SBAR(); \
        ATT_MM(PN0, kf[4], qr[2]); ATT_EP(PC1, 0, w2, 0); ATT_VREAD(0, vb_); ATT_VREAD(1, vb_); ATT_SBAR(); \
        ATT_MM(PN1, kf[5], qr[2]); ATT_EP(PC1, 2, w2, 1); ATT_VREAD(2, vb_); ATT_SBAR(); \
        ATT_MM(PN0, kf[6], qr[3]); ATT_EP(PC1, 4, w2, 2); ATT_VREAD(3, vb_); ATT_SBAR(); \
        ATT_MM(PN1, kf[7], qr[3]); ATT_EP(PC1, 6, w2, 3); ATT_VREAD(4, vb_); ATT_SBAR(); \
        if (KS > 4) { ATT_MM(PN0, kf[2 * KS - 4], qr[KS - 2]); ATT_EP(PC1, 8, w3, 0); ATT_VREAD(5, vb_); ATT_SBAR(); \
                      ATT_MM(PN1, kf[2 * KS - 3], qr[KS - 2]); ATT_EP(PC1, 10, w3, 1); ATT_VREAD(6, vb_); ATT_SBAR(); \
                      ATT_MM(PN0, kf[2 * KS - 2], qr[KS - 1]); ATT_EP(PC1, 12, w3, 2); ATT_VREAD(7, vb_); ATT_SBAR(); \
                      ATT_MM(PN1, kf[2 * KS - 1], qr[KS - 1]); ATT_EP(PC1, 14, w3, 3); ATT_SBAR(); } \
        else { ATT_EP(PC1, 8, w3, 0); ATT_EP(PC1, 10, w3, 1); ATT_VREAD(5, vb_); ATT_VREAD(6, vb_); ATT_EP(PC1, 12, w3, 2); ATT_EP(PC1, 14, w3, 3); ATT_VREAD(7, vb_); ATT_SBAR(); } \
        lsum += lacc; \
        ATT_MM(o0, ATT_VF(0), __builtin_bit_cast(bf16x8, w0)); ATT_SM4(PN0, PN1, 0, kvn_); if (kmore_) ATT_KRD(kslot_, 0); ATT_SBAR(); \
        ATT_MM(o1, ATT_VF(1), __builtin_bit_cast(bf16x8, w0)); ATT_SM4(PN0, PN1, 2, kvn_); if (kmore_) ATT_KRD(kslot_, 1); ATT_SBAR(); \
        ATT_MM(o0, ATT_VF(2), __builtin_bit_cast(bf16x8, w1)); ATT_SM4(PN0, PN1, 4, kvn_); if (kmore_) ATT_KRD(kslot_, 2); ATT_SBAR(); \
        ATT_MM(o1, ATT_VF(3), __builtin_bit_cast(bf16x8, w1)); ATT_SM4(PN0, PN1, 6, kvn_); if (kmore_) ATT_KRD(kslot_, 3); ATT_SBAR(); \
        ATT_MM(o0, ATT_VF(4), __builtin_bit_cast(bf16x8, w2)); ATT_SM4(PN0, PN1, 8, kvn_); if (KS > 4) { if (kmore_) ATT_KRD(kslot_, KS - 2); } ATT_SBAR(); \
        ATT_MM(o1, ATT_VF(5), __builtin_bit_cast(bf16x8, w2)); ATT_SM4(PN0, PN1, 10, kvn_); if (KS > 4) { if (kmore_) ATT_KRD(kslot_, KS - 1); } ATT_SBAR(); \
        ATT_MM(o0, ATT_VF(6), __builtin_bit_cast(bf16x8, w3)); ATT_SM4(PN0, PN1, 12, kvn_); ATT_SBAR(); \
        ATT_MM(o1, ATT_VF(7), __builtin_bit_cast(bf16x8, w3)); ATT_SM4(PN0, PN1, 14, kvn_); ATT_SBAR(); \
        ATT_DECIDE(PN0, PN1, lacc); \
        if ((tt) + 3 < NT) ATT_STOREK(((tt) + 1) & 1); ATT_STOREV(((tt) + 1) & 1); \
        __syncthreads(); } while (0)
    ATT_LOADK(0); ATT_LOADV(0); ATT_STOREK(0); ATT_STOREV(0); ATT_LOADK(1); ATT_STOREK(1);
    __syncthreads();
    ATT_KREAD(0); ATT_SBAR();
    pA0 = __builtin_amdgcn_mfma_f32_32x32x16_bf16(kf[0], qr[0], (f32x16){}, 0, 0, 0); pA1 = __builtin_amdgcn_mfma_f32_32x32x16_bf16(kf[1], qr[0], (f32x16){}, 0, 0, 0);
#pragma unroll
    for (int ks = 1; ks < KS; ++ks) { ATT_MM(pA0, kf[2 * ks], qr[ks]); ATT_MM(pA1, kf[2 * ks + 1], qr[ks]); }
#pragma unroll
    for (int r = 0; r < 16; ++r) { pA0[r] -= mrun; pA1[r] -= mrun; }
#pragma unroll
    for (int r = 0; r < 16; r += 2) ATT_SM4(pA0, pA1, r, kvs);
    if (MODE == 0) {
        float rm = fmaxf(fmaxf(pA0[0], pA1[0]), fmaxf(pA0[1], pA1[1]));
#pragma unroll
        for (int r = 2; r < 16; r += 2) rm = fmaxf(fmaxf(rm, fmaxf(pA0[r], pA1[r])), fmaxf(pA0[r + 1], pA1[r + 1]));
        rm = hswap_max(rm); mrun = rm;
#pragma unroll
        for (int r = 0; r < 16; ++r) { pA0[r] -= rm; pA1[r] -= rm; }
    }
#pragma unroll
    for (int r = 0; r < 16; ++r) negm[r] = -mrun;
    ATT_KREAD(1);
    __syncthreads();
    ATT_LOADK(2); ATT_STOREK(0);
    __syncthreads();
    for (int t = 0; t + 2 < NT; t += 2) { ATT_STEP(pA0, pA1, pB0, pB1, t); ATT_STEP(pB0, pB1, pA0, pA1, t + 1); }
    ATT_STEP(pA0, pA1, pB0, pB1, NT - 2);
    {
        const LAS unsigned char* vb_ = lds + ((NT - 1) & 1) * ATT_VBYTES; float lacc = 0.f;
#pragma unroll
        for (int i = 0; i < 8; ++i) ATT_VREAD(i, vb_);
        ATT_EP(pB0, 0, w0, 0); ATT_EP(pB0, 2, w0, 1); ATT_EP(pB0, 4, w0, 2); ATT_EP(pB0, 6, w0, 3); ATT_EP(pB0, 8, w1, 0); ATT_EP(pB0, 10, w1, 1); ATT_EP(pB0, 12, w1, 2); ATT_EP(pB0, 14, w1, 3);
        ATT_EP(pB1, 0, w2, 0); ATT_EP(pB1, 2, w2, 1); ATT_EP(pB1, 4, w2, 2); ATT_EP(pB1, 6, w2, 3); ATT_EP(pB1, 8, w3, 0); ATT_EP(pB1, 10, w3, 1); ATT_EP(pB1, 12, w3, 2); ATT_EP(pB1, 14, w3, 3);
        lsum += lacc;
        ATT_MM(o0, ATT_VF(0), __builtin_bit_cast(bf16x8, w0)); ATT_MM(o1, ATT_VF(1), __builtin_bit_cast(bf16x8, w0)); ATT_MM(o0, ATT_VF(2), __builtin_bit_cast(bf16x8, w1)); ATT_MM(o1, ATT_VF(3), __builtin_bit_cast(bf16x8, w1));
        ATT_MM(o0, ATT_VF(4), __builtin_bit_cast(bf16x8, w2)); ATT_MM(o1, ATT_VF(5), __builtin_bit_cast(bf16x8, w2)); ATT_MM(o0, ATT_VF(6), __builtin_bit_cast(bf16x8, w3)); ATT_MM(o1, ATT_VF(7), __builtin_bit_cast(bf16x8, w3));
        __syncthreads();
    }
#undef ATT_LOADK
#undef ATT_LOADV
#undef ATT_STOREK
#undef ATT_STOREV
#undef ATT_KREAD
#undef ATT_VREAD
#undef ATT_VF
#undef ATT_MM
#undef ATT_EP
#undef ATT_SM4
#undef ATT_DECIDE
#undef ATT_STEP
    __builtin_amdgcn_s_setprio(0);
    const float inv = 1.0f / hswap_sum(lsum);
    const int lane2 = opaque_tid(wv) & 63, l32b = lane2 & 31, hib = lane2 >> 5;
    LAS unsigned char* stg = lds + ATT_OST_OFF + wid * (32 * 144);
#pragma unroll
    for (int g = 0; g < 4; ++g) {
        u32x2 a, c; a.x = cvtpk(o0[4 * g] * inv, o0[4 * g + 1] * inv); a.y = cvtpk(o0[4 * g + 2] * inv, o0[4 * g + 3] * inv);
        c.x = cvtpk(o1[4 * g] * inv, o1[4 * g + 1] * inv); c.y = cvtpk(o1[4 * g + 2] * inv, o1[4 * g + 3] * inv);
        *(LAS u32x2*)(stg + l32b * 144 + (8 * g + 4 * hib) * 2) = a; *(LAS u32x2*)(stg + l32b * 144 + 64 + (8 * g + 4 * hib) * 2) = c;
    }
    bf16* obase = T.O + (rowbase + q0 + wid * 32) * DM + ocol;
#pragma unroll
    for (int i = 0; i < 4; ++i) { const int row = i * 8 + (lane2 >> 3), ch = lane2 & 7;
        const u32x4 v = *(const LAS u32x4*)(stg + row * 144 + ch * 16); *(u32x4*)(obase + (size_t)row * DM + ch * 8) = v; }
}
__device__ __forceinline__ void group_barrier(unsigned* word, unsigned& gen, unsigned nmem, const int wv, const bool xlocal) {
    asm volatile("s_waitcnt vmcnt(0)" ::: "memory");
    __syncthreads();
    if (opaque_tid(wv) == 0) {
        if (!xlocal) __builtin_amdgcn_fence(__ATOMIC_RELEASE, "agent");
        asm volatile("s_waitcnt vmcnt(0)" ::: "memory");
        const unsigned want = nmem * (gen + 1u);
        (void)__hip_atomic_fetch_add(word, 1u, __ATOMIC_RELAXED, __HIP_MEMORY_SCOPE_AGENT);
        unsigned sp = 0u;
        while (__hip_atomic_load(word, __ATOMIC_RELAXED, __HIP_MEMORY_SCOPE_AGENT) < want) { __builtin_amdgcn_s_sleep(1); if (++sp > (1u << 22)) break; }
        __builtin_amdgcn_fence(__ATOMIC_ACQUIRE, "agent");
        asm volatile("s_waitcnt vmcnt(0)" ::: "memory");
    }
    gen += 1u;
    __syncthreads();
}

#ifndef MK_SYNC
#define MK_SYNC() group_barrier(gword, ggen, gmem, wv, xlocal)
#endif
#define ARGP() ({ ArgP p_ = (ArgP)__builtin_amdgcn_kernarg_segment_ptr(); asm volatile("" : "+s"(p_)); p_; })
#define PH_IDS() const int tid = opaque_tid(wv), lane = tid & 63; const int wave = __builtin_amdgcn_readfirstlane(tid >> 6); const int gw = vcu * NWAVES + wave, NGW = G * NWAVES; (void)lane; (void)gw; (void)NGW
__global__ void __launch_bounds__(NTHREADS) mk_fwd(Args a_unused) {
    extern __shared__ __attribute__((aligned(16))) unsigned char lds_raw[];
    LAS unsigned char* lds = (LAS unsigned char*)lds_raw;
    cg::grid_group grid = cg::this_grid();
    const int wv = __builtin_amdgcn_readfirstlane(threadIdx.x >> 6);
    const int G = gridDim.x, bx = blockIdx.x; const int vcu = (G % 8 == 0) ? (bx % 8) * (G / 8) + bx / 8 : bx;
    const int grp = bx & 7, lcu = bx >> 3;
    unsigned* gword = (unsigned*)(ARGP()->ws) + CW_GRP + 64 * grp; unsigned ggen = 0u; const unsigned gmem = 32u;
    if (threadIdx.x == 0) { const unsigned xcc = (unsigned)__builtin_amdgcn_s_getreg((3 << 11) | 20) & 0xFu; (void)__hip_atomic_fetch_or((unsigned*)(ARGP()->ws) + CW_XM + 64 * grp, 1u << xcc, __ATOMIC_RELAXED, __HIP_MEMORY_SCOPE_AGENT); }

    { PH_IDS(); ArgP ap = ARGP(); prologue(ap, lds, gw, NGW, lane, wave); }
    grid.sync();
    const bool xlocal = __builtin_popcount(__builtin_amdgcn_readfirstlane(__hip_atomic_load((unsigned*)(ARGP()->ws) + CW_XM + 64 * grp, __ATOMIC_RELAXED, __HIP_MEMORY_SCOPE_AGENT))) == 1;
    for (int L = 0; L < DEPTH; ++L) {
        for (int f = 0; f < 2; ++f) {
            { ArgP ap = ARGP(); unsigned char* ws = ap->ws; const unsigned char* wl = ws + WS_W + (size_t)L * WL_BYTES;
              pg8::Gemm g{(const bf16*)(ws + WS_XB), (const bf16*)(wl + (f ? WO_GU2 : WO_GU1)), MTOK, 2 * FF, DM}; pg8::StaticOrder S; S.init(MTOK, 2 * FF, G, bx);
              pg8::EpiSwiGLU E{(bf16*)(GB(ws, grp, OFF_ACT, FF)), FF, (const float*)(ws + WS_RS)}; pg8::gemm_phase<pg8::EpiSwiGLU, pg8::StaticOrder, true, true>(lds, g, S, E, wv); }
            MK_SYNC();
            { ArgP ap = ARGP(); unsigned char* ws = ap->ws; const unsigned char* wl = ws + WS_W + (size_t)L * WL_BYTES;
              pg8::Gemm g{(const bf16*)(GB(ws, grp, OFF_ACT, FF)), (const bf16*)(wl + (f ? WO_D2 : WO_D1)), MTOK, DM, FF}; pg8::StaticOrder S; S.init(MTOK, DM, G, bx);
              pg8::EpiStore E{(bf16*)(ws + WS_Y), DM}; pg8::gemm_phase<pg8::EpiStore, pg8::StaticOrder, true, true>(lds, g, S, E, wv); }
            MK_SYNC();
            { PH_IDS(); ArgP ap = ARGP(); unsigned char* ws = ap->ws; bf16* XB = (bf16*)(ws + WS_XB);
              const int mstart = SEQ * grp + lcu * NWAVES + wave, mend = SEQ * (grp + 1), mstep = 32 * NWAVES;
              const float* gpost = f ? ap->in[20] + L * DM : ap->in[6] + L * DM; float* rs = (float*)(ws + WS_RS);
              if (L == 0 && f == 0) norm_pass<false, true>((const bf16*)(ws + WS_Y), ap->in[0], XB, gpost, 0.5f, rs, mstart, mend, mstep, lane);
              else if (L == DEPTH - 1 && f == 1) norm_pass<true, false>((const bf16*)(ws + WS_Y), XB, ap->out, gpost, 0.5f, nullptr, mstart, mend, mstep, lane);
              else norm_pass<true, true>((const bf16*)(ws + WS_Y), XB, XB, gpost, 0.5f, rs, mstart, mend, mstep, lane); }
            if (f == 1) { if (L + 1 < DEPTH) MK_SYNC(); continue; }
            MK_SYNC();
            { ArgP ap = ARGP(); unsigned char* ws = ap->ws; const unsigned char* wl = ws + WS_W + (size_t)L * WL_BYTES;
              pg8::Gemm g{(const bf16*)(ws + WS_XB), (const bf16*)(wl + WO_WIN), MTOK, INPAD, DM}; pg8::StaticOrder S; S.init(MTOK, INPAD, G, bx);
              pg8::EpiWin E{(bf16*)(GB(ws, grp, OFF_CQ, 384)), (bf16*)(GB(ws, grp, OFF_CKV, 256)), (bf16*)(GB(ws, grp, OFF_KR, 32)), (bf16*)(GB(ws, grp, OFF_QB, 512)), (bf16*)(GB(ws, grp, OFF_KB, 128)), (bf16*)(GB(ws, grp, OFF_VB, 128)), (float*)(ws + WS_STAT), (const float*)(ws + WS_ROPE), QSCALE_B, (const float*)(ws + WS_RS)};
              pg8::gemm_phase<pg8::EpiWin, pg8::StaticOrder, true, true>(lds, g, S, E, wv); }
            MK_SYNC();
            { ArgP ap = ARGP(); unsigned char* ws = ap->ws; const unsigned char* wl = ws + WS_W + (size_t)L * WL_BYTES;
              pg8::Gemm g{(const bf16*)(GB(ws, grp, OFF_CQ, 384)), (const bf16*)(wl + WO_UQ), MTOK, 768, QRANK}; pg8::StaticOrder S; S.init(MTOK, 768, G, bx);
              pg8::EpiUq E{(bf16*)(GB(ws, grp, OFF_Q, 768)), (const float*)(ws + WS_STAT), (const float*)(ws + WS_ROPE), QSCALE_A}; pg8::gemm_phase<pg8::EpiUq, pg8::StaticOrder, true, true>(lds, g, S, E, wv); }
            { ArgP ap = ARGP(); unsigned char* ws = ap->ws; const unsigned char* wl = ws + WS_W + (size_t)L * WL_BYTES;
              pg8::Gemm g{(const bf16*)(GB(ws, grp, OFF_CKV, 256)), (const bf16*)(wl + WO_UKV), MTOK, 1024, KVRANK}; pg8::StaticOrder S; S.init(MTOK, 1024, G, bx);
              pg8::EpiUkv E{(bf16*)(GB(ws, grp, OFF_KN, 512)), (bf16*)(GB(ws, grp, OFF_V, 512)), (const float*)(ws + WS_STAT)}; pg8::gemm_phase<pg8::EpiUkv, pg8::StaticOrder, true, true>(lds, g, S, E, wv); }
            {
              PH_IDS(); ArgP ap = ARGP(); unsigned char* ws = ap->ws; const float* btab = (const float*)(ws + WS_BTAB); const float* sink = ap->in[13] + L * 8;
              LAS float* bt = (LAS float*)(lds + ATT_BT_OFF);
              for (int e = tid; e < 8 * 260; e += NTHREADS) bt[e] = btab[e];
              __syncthreads();
              const AttnT T{(const bf16*)(GB(ws, grp, OFF_QB, 512)), 512, (const bf16*)(GB(ws, grp, OFF_KB, 128)), 128, nullptr, (const bf16*)(GB(ws, grp, OFF_VB, 128)), 128, (bf16*)(GB(ws, grp, OFF_O, 1024))};
              for (int u = lcu; u < 256; u += 32) { const int h = u >> 5, qb = u & 31, b = grp;
                  attn_unit<1>(lds, T, b, qb * 256, h * 64, (h >> 2) * 64, (h >> 2) * 64, 512 + h * 64, sink[h] * LOG2E, bt + h * 260, wv); } }
            MK_SYNC();
            { ArgP ap = ARGP(); unsigned char* ws = ap->ws;
              const AttnT T{(const bf16*)(GB(ws, grp, OFF_Q, 768)), 768, (const bf16*)(GB(ws, grp, OFF_KN, 512)), 512, (const bf16*)(GB(ws, grp, OFF_KR, 32)), (const bf16*)(GB(ws, grp, OFF_V, 512)), 512, (bf16*)(GB(ws, grp, OFF_O, 1024))};
              for (int u = lcu; u < 256; u += 32) { const int h = u >> 5, qb = u & 31, b = grp;
                  attn_unit<0>(lds, T, b, qb * 256, h * 96, h * 64, h * 64, h * 64, 0.f, nullptr, wv); } }
            MK_SYNC();
            { ArgP ap = ARGP(); unsigned char* ws = ap->ws; const unsigned char* wl = ws + WS_W + (size_t)L * WL_BYTES;
              pg8::Gemm g{(const bf16*)(GB(ws, grp, OFF_O, 1024)), (const bf16*)(wl + WO_OUT), MTOK, DM, DM}; pg8::StaticOrder S; S.init(MTOK, DM, G, bx);
              pg8::EpiStore E{(bf16*)(ws + WS_Y), DM}; pg8::gemm_phase<pg8::EpiStore, pg8::StaticOrder, true, true>(lds, g, S, E, wv); }
            MK_SYNC();
            { PH_IDS(); ArgP ap = ARGP(); unsigned char* ws = ap->ws; bf16* XB = (bf16*)(ws + WS_XB);
              const int mstart = SEQ * grp + lcu * NWAVES + wave, mend = SEQ * (grp + 1), mstep = 32 * NWAVES;
              norm_pass<true, true>((const bf16*)(ws + WS_Y), XB, XB, ap->in[15] + L * DM, 1.0f, (float*)(ws + WS_RS), mstart, mend, mstep, lane); }
            MK_SYNC();
        }
    }
}

extern "C" void kernel_launch(void* const* d_in, const int* in_sizes, int n_in, void* d_out, int out_size, void* d_ws, size_t ws_size, hipStream_t stream) {
    static int grid = 0;
    if (grid == 0) {
        if (n_in != 21 || in_sizes[0] != MTOK * DM || out_size != MTOK * DM || ws_size < WS_END) { fprintf(stderr, "kernel_launch: unexpected shapes / workspace (n_in %d, ws %zu)\n", n_in, ws_size); grid = -1; return; }
        int dev = 0, cus = 0, per_cu = 0;
        (void)hipGetDevice(&dev); (void)hipDeviceGetAttribute(&cus, hipDeviceAttributeMultiprocessorCount, dev);
        (void)hipFuncSetAttribute((const void*)mk_fwd, hipFuncAttributeMaxDynamicSharedMemorySize, LDS_BYTES);
        if (hipOccupancyMaxActiveBlocksPerMultiprocessor(&per_cu, (const void*)mk_fwd, NTHREADS, LDS_BYTES) != hipSuccess || per_cu < 1) per_cu = 1;
        (void)hipGetLastError();
        grid = cus * per_cu;
        if (grid < 256) { fprintf(stderr, "kernel_launch: this kernel needs 256 co-resident workgroups (got %d)\n", grid); grid = -1; return; }
        grid = 256;
    }
    if (grid < 0) return;
    if (hipMemsetAsync(d_ws, 0, CTL_ZERO_BYTES, stream) != hipSuccess) { fprintf(stderr, "kernel_launch: memset of the barrier words failed\n"); return; }
    Args a{};
    for (int i = 0; i < 21; ++i) a.in[i] = (const float*)d_in[i];
    a.out = (float*)d_out; a.ws = (unsigned char*)d_ws;
    void* args[] = {&a};
    hipError_t e = hipLaunchCooperativeKernel((const void*)mk_fwd, dim3(grid), dim3(NTHREADS), args, LDS_BYTES, stream);
    if (e != hipSuccess) fprintf(stderr, "cooperative launch failed: %s (grid %d)\n", hipGetErrorString(e), grid);
}
```

```cpp
#include <hip/hip_runtime.h>
#include <hip/hip_cooperative_groups.h>
#include <cstdio>
#include <cstdint>
namespace cg = cooperative_groups;
__device__ __forceinline__ int opaque_tid(int wv) { unsigned z = 0u; asm volatile("" : "+v"(z)); return (wv << 6) + (int)__builtin_amdgcn_mbcnt_hi(~0u, __builtin_amdgcn_mbcnt_lo(~0u, z)); }
__device__ __forceinline__ float bperm_xor(float v, int lane, int mask) { return __builtin_bit_cast(float, __builtin_amdgcn_ds_bpermute((lane ^ mask) << 2, __builtin_bit_cast(int, v))); }
namespace pg8 {
#define PG8_LAS __attribute__((address_space(3)))
typedef unsigned short bf16_t;
typedef short bf16x8 __attribute__((ext_vector_type(8)));
typedef float f32x4 __attribute__((ext_vector_type(4)));
typedef unsigned u32x4 __attribute__((ext_vector_type(4)));
constexpr int BM = 256, BK = 64, HALF = 128, HTB = HALF * BK * 2  , STAGE_BYTES = 8 * HTB, NXCD = 8, WGM = 8;

__host__ __device__ __forceinline__ int lds_byte(int r, int c) { const int st = (r >> 4) * 2 + (c >> 5), rr = r & 15, cc = c & 31, ob = rr * 64 + cc * 2; return st * 1024 + (ob ^ (((ob >> 9) & 1) << 5)); }
__host__ __device__ __forceinline__ void stage_rc(int b, int& R, int& C) { const int st = b / 1024, sb = b % 1024, swz = sb ^ (((sb >> 9) & 1) << 5); R = (st >> 1) * 16 + swz / 64; C = (st & 1) * 32 + (swz % 64) / 2; }
__host__ __device__ __forceinline__ int perm32(int rho) { const int n = rho >> 4, i = rho & 15; return 8 * (i >> 2) + 4 * n + (i & 3); }

struct Unit { int pm, pn; };
struct Gemm { const bf16_t* A; const bf16_t* Bt; int M, N, K; };

struct StaticOrder {
    int nM, nN, nwg, G, c;
    __host__ __device__ void init(int M, int N, int G_, int c_) { nM = M / BM; nN = N / BM; nwg = nM * nN; G = G_; c = c_; }
    __host__ __device__ bool next(int i, Unit& u) const {
        const long L = (long)i * G + c; if (L >= nwg) return false;
        int wgid = (int)L; { const int q = nwg / NXCD, r = nwg % NXCD, xcd = wgid % NXCD, off = wgid / NXCD; wgid = (xcd < r ? xcd * (q + 1) : r * (q + 1) + (xcd - r) * q) + off; }
        const int nig = WGM * nN, gid = wgid / nig, fm = gid * WGM, gsz = (nM - fm) < WGM ? (nM - fm) : WGM;
        u.pm = fm + ((wgid % nig) % gsz); u.pn = (wgid % nig) / gsz; return true;
    }
    __device__ __forceinline__ void a_ready(const Unit&) const {}
    __device__ __forceinline__ void done(const Unit&) const {}
};

typedef float f32x2 __attribute__((ext_vector_type(2))); typedef __bf16 bf16x2v __attribute__((ext_vector_type(2)));
__device__ __forceinline__ unsigned cvt_pk_bf16(float lo, float hi) { f32x2 v = {lo, hi}; bf16x2v b = __builtin_convertvector(v, bf16x2v); return __builtin_bit_cast(unsigned, b); }
constexpr int SEQ_ = 8192;
__device__ __forceinline__ u32x4 pack8(const f32x4& a, const f32x4& b) { u32x4 w; w.x = cvt_pk_bf16(a[0], a[1]); w.y = cvt_pk_bf16(a[2], a[3]); w.z = cvt_pk_bf16(b[0], b[1]); w.w = cvt_pk_bf16(b[2], b[3]); return w; }
__device__ __forceinline__ float silu_mul(float g, float u) { return g * u * __builtin_amdgcn_rcpf(1.f + __builtin_amdgcn_exp2f(-1.4426950408889634f * g)); }
__device__ __forceinline__ void rope8(f32x4& a, f32x4& b, const f32x4 c4, const f32x4 s4) {
    const f32x4 a0 = a, b0 = b;
    a[0] = a0[0] * c4[0] - a0[1] * s4[0]; a[1] = a0[1] * c4[0] + a0[0] * s4[0];
    a[2] = a0[2] * c4[1] - a0[3] * s4[1]; a[3] = a0[3] * c4[1] + a0[2] * s4[1];
    b[0] = b0[0] * c4[2] - b0[1] * s4[2]; b[1] = b0[1] * c4[2] + b0[0] * s4[2];
    b[2] = b0[2] * c4[3] - b0[3] * s4[3]; b[3] = b0[3] * c4[3] + b0[2] * s4[3];
}
struct EpiStore {
    static constexpr bool PERM = true, AFTER_DRAIN = false;
    bf16_t* O; int ldc;
    __device__ __forceinline__ void operator()(const f32x4 (&acc)[2][2][4][2], const Unit& u, int wr, int wc, int fr, int fq) const {
        const int row0 = u.pm * BM + wr * 64 + fr, col0 = u.pn * BM + wc * 32 + 8 * fq;
#pragma unroll
        for (int ai = 0; ai < 2; ++ai)
#pragma unroll
            for (int m = 0; m < 4; ++m) { bf16_t* rowp = O + (size_t)(row0 + ai * HALF + m * 16) * ldc + col0;
#pragma unroll
                for (int bj = 0; bj < 2; ++bj) *(u32x4*)(rowp + bj * HALF) = pack8(acc[ai][bj][m][0], acc[ai][bj][m][1]); }
    }
};
struct EpiSwiGLU {
    static constexpr bool PERM = true, AFTER_DRAIN = false;
    bf16_t* O; int ldc; const float* rs;
    __device__ __forceinline__ void operator()(const f32x4 (&acc)[2][2][4][2], const Unit& u, int wr, int wc, int fr, int fq) const {
        const int row0 = u.pm * BM + wr * 64 + fr, col0 = u.pn * HALF + wc * 32 + 8 * fq;
#pragma unroll
        for (int ai = 0; ai < 2; ++ai)
#pragma unroll
            for (int m = 0; m < 4; ++m) { f32x4 r0, r1; const float r = rs[row0 + ai * HALF + m * 16];
#pragma unroll
                for (int e = 0; e < 4; ++e) { r0[e] = silu_mul(acc[ai][0][m][0][e] * r, acc[ai][1][m][0][e] * r); r1[e] = silu_mul(acc[ai][0][m][1][e] * r, acc[ai][1][m][1][e] * r); }
                *(u32x4*)(O + (size_t)(row0 + ai * HALF + m * 16) * ldc + col0) = pack8(r0, r1); }
    }
};
struct EpiWin {
    static constexpr bool PERM = true, AFTER_DRAIN = false;
    bf16_t *CQ, *CKV, *KR, *QB, *KB, *VB; float* stat; const float* rope; float qbscale; const float* rs;
    __device__ __forceinline__ void operator()(const f32x4 (&acc)[2][2][4][2], const Unit& u, int wr, int wc, int fr, int fq) const {
        const int row0 = u.pm * BM + wr * 64 + fr;
#pragma unroll
        for (int bj = 0; bj < 2; ++bj) {
            const int c32 = u.pn * BM + bj * HALF + wc * 32;
            if (c32 >= 1440) continue;
            if (c32 < 640) {
                const bool isq = c32 < 384; bf16_t* base = isq ? CQ : CKV; const int ld = isq ? 384 : 256, col = (isq ? c32 : c32 - 384) + 8 * fq;
#pragma unroll
                for (int ai = 0; ai < 2; ++ai)
#pragma unroll
                    for (int m = 0; m < 4; ++m) { const int row = row0 + ai * HALF + m * 16; const float r = rs[row]; const f32x4 a = acc[ai][bj][m][0] * r, b = acc[ai][bj][m][1] * r;
                        *(u32x4*)(base + (size_t)row * ld + col) = pack8(a, b);
                        float s = (a[0] * a[0] + a[1] * a[1]) + (a[2] * a[2] + a[3] * a[3]) + (b[0] * b[0] + b[1] * b[1]) + (b[2] * b[2] + b[3] * b[3]);
                        s += bperm_xor(s, fq * 16 + fr, 16); s += bperm_xor(s, fq * 16 + fr, 32);
                        if (fq == 0) stat[(size_t)row * 20 + (c32 >> 5)] = s; }
            } else if (c32 == 640) {
#pragma unroll
                for (int ai = 0; ai < 2; ++ai)
#pragma unroll
                    for (int m = 0; m < 4; ++m) { const int row = row0 + ai * HALF + m * 16, pos = row & (SEQ_ - 1); const float r = rs[row]; f32x4 a = acc[ai][bj][m][0] * r, b = acc[ai][bj][m][1] * r;
                        const f32x4 c4 = *(const f32x4*)(rope + (size_t)pos * 32 + 4 * fq), s4 = *(const f32x4*)(rope + (size_t)pos * 32 + 16 + 4 * fq);
                        rope8(a, b, c4, s4);
                        *(u32x4*)(KR + (size_t)row * 32 + 8 * fq) = pack8(a, b); }
            } else {
                bf16_t* base; int ld, col; float sc = 1.f;
                if (c32 < 1184) { base = QB; ld = 512; col = c32 - 672; sc = qbscale; } else if (c32 < 1312) { base = KB; ld = 128; col = c32 - 1184; } else { base = VB; ld = 128; col = c32 - 1312; }
                col += 8 * fq;
#pragma unroll
                for (int ai = 0; ai < 2; ++ai)
#pragma unroll
                    for (int m = 0; m < 4; ++m) { const int row = row0 + ai * HALF + m * 16; const float r = rs[row] * sc;
                        *(u32x4*)(base + (size_t)row * ld + col) = pack8(acc[ai][bj][m][0] * r, acc[ai][bj][m][1] * r); }
            }
        }
    }
};
struct EpiUq {
    static constexpr bool PERM = true, AFTER_DRAIN = false;
    bf16_t* Q; const float* stat; const float* rope; float qscale;
    __device__ __forceinline__ void operator()(const f32x4 (&acc)[2][2][4][2], const Unit& u, int wr, int wc, int fr, int fq) const {
        const int row0 = u.pm * BM + wr * 64 + fr;
#pragma unroll
        for (int ai = 0; ai < 2; ++ai)
#pragma unroll
            for (int m = 0; m < 4; ++m) { const int row = row0 + ai * HALF + m * 16, pos = row & (SEQ_ - 1);
                const f32x4* sp = (const f32x4*)(stat + (size_t)row * 20); const f32x4 s0 = sp[0], s1 = sp[1], s2 = sp[2];
                const float ssq = ((s0[0] + s0[1]) + (s0[2] + s0[3])) + ((s1[0] + s1[1]) + (s1[2] + s1[3])) + ((s2[0] + s2[1]) + (s2[2] + s2[3]));
                const float rs = __builtin_amdgcn_rsqf(ssq * (1.0f / 384.0f) + 1e-6f) * qscale;
#pragma unroll
                for (int bj = 0; bj < 2; ++bj) { const int c32 = u.pn * BM + bj * HALF + wc * 32; f32x4 a = acc[ai][bj][m][0] * rs, b = acc[ai][bj][m][1] * rs;
                    if ((c32 % 96) == 64) { const f32x4 c4 = *(const f32x4*)(rope + (size_t)pos * 32 + 4 * fq), s4 = *(const f32x4*)(rope + (size_t)pos * 32 + 16 + 4 * fq); rope8(a, b, c4, s4); }
                    *(u32x4*)(Q + (size_t)row * 768 + c32 + 8 * fq) = pack8(a, b); } }
    }
};
struct EpiUkv {
    static constexpr bool PERM = true, AFTER_DRAIN = false;
    bf16_t *KN, *V; const float* stat;
    __device__ __forceinline__ void operator()(const f32x4 (&acc)[2][2][4][2], const Unit& u, int wr, int wc, int fr, int fq) const {
        const int row0 = u.pm * BM + wr * 64 + fr; const int colt = u.pn * BM; bf16_t* base = colt < 512 ? KN : V; const int col0 = (colt & 511) + wc * 32 + 8 * fq;
#pragma unroll
        for (int ai = 0; ai < 2; ++ai)
#pragma unroll
            for (int m = 0; m < 4; ++m) { const int row = row0 + ai * HALF + m * 16;
                const f32x4* sp = (const f32x4*)(stat + (size_t)row * 20 + 12); const f32x4 s0 = sp[0], s1 = sp[1];
                const float ssq = ((s0[0] + s0[1]) + (s0[2] + s0[3])) + ((s1[0] + s1[1]) + (s1[2] + s1[3]));
                const float rs = __builtin_amdgcn_rsqf(ssq * (1.0f / 256.0f) + 1e-6f);
#pragma unroll
                for (int bj = 0; bj < 2; ++bj) *(u32x4*)(base + (size_t)row * 512 + col0 + bj * HALF) = pack8(acc[ai][bj][m][0] * rs, acc[ai][bj][m][1] * rs); }
    }
};
template <class Epi, class Sched, bool ALIGN_EPI = false, bool SP2 = false>
__device__ __forceinline__ void gemm_phase(PG8_LAS unsigned char* lds, const Gemm g, const Sched& S, const Epi& E, const int wv) {
    const int tid = opaque_tid(wv), wid = __builtin_amdgcn_readfirstlane(tid >> 6), lane = tid & 63, wr = wid >> 2, wc = wid & 3, fr = lane & 15, fq = lane >> 4;
    const int K = g.K, nt = K / BK;
    unsigned voffA[2], voffB[2];
#pragma unroll
    for (int i = 0; i < 2; ++i) { int R, C; stage_rc(tid * 16 + i * 8192, R, C); const int Rb = Epi::PERM ? ((R & ~31) + perm32(R & 31)) : R;
        voffA[i] = (unsigned)(R * K + C) * 2u; voffB[i] = (unsigned)(Rb * K + C) * 2u; }
    const size_t kstep = (size_t)(BK * 2);
    const size_t hstep = (size_t)HALF * K * 2;
    const size_t tstep = 2 * hstep;
    const unsigned ldsw = (unsigned)wid * 1024u;
    const int aoff = lds_byte(wr * 64 + fr, fq * 8), boff = lds_byte(wc * 32 + fr, fq * 8);
#define PG8_SA(b, h) (((b) * 2 + (h)) * HTB)
#define PG8_SB(b, h) ((4 + (b) * 2 + (h)) * HTB)
#define PG8_STAGE(bufoff, gbase, voff) do { _Pragma("unroll") for (int _i = 0; _i < 2; ++_i) \
        __builtin_amdgcn_global_load_lds((const unsigned*)((const char*)(gbase) + (voff)[_i]), (PG8_LAS unsigned*)(lds + (bufoff) + ldsw + _i * 8192), 16, 0, 0); } while (0)
#define PG8_LDA(dst, b, h) do { _Pragma("unroll") for (int m = 0; m < 4; ++m) _Pragma("unroll") for (int k = 0; k < 2; ++k) dst[m][k] = *(const PG8_LAS bf16x8*)(lds + PG8_SA(b, h) + aoff + m * 2048 + k * 1024); } while (0)
#define PG8_LDB(dst, b, h) do { _Pragma("unroll") for (int n = 0; n < 2; ++n) _Pragma("unroll") for (int k = 0; k < 2; ++k) dst[n][k] = *(const PG8_LAS bf16x8*)(lds + PG8_SB(b, h) + boff + n * 2048 + k * 1024); } while (0)
#define PG8_MMA(ai, bj, At, Bt) do { __builtin_amdgcn_s_setprio(1); _Pragma("unroll") for (int m = 0; m < 4; ++m) _Pragma("unroll") for (int n = 0; n < 2; ++n) _Pragma("unroll") for (int k = 0; k < 2; ++k) \
        acc[ai][bj][m][n] = __builtin_amdgcn_mfma_f32_16x16x32_bf16(Bt[n][k], At[m][k], acc[ai][bj][m][n], 0, 0, 0); __builtin_amdgcn_s_setprio(0); } while (0)
#define PG8_WAIT_V(n) asm volatile("s_waitcnt vmcnt(" #n ")" ::: "memory")
#define PG8_WAIT_L(n) asm volatile("s_waitcnt lgkmcnt(" #n ")" ::: "memory")
#define PG8_BAR __builtin_amdgcn_s_barrier()
#define PG8_SCHED __builtin_amdgcn_sched_barrier(0)
    Unit cur, nxt; int ui = 0;
    if (!S.next(0, cur)) return;
    f32x4 acc[2][2][4][2];
#pragma unroll
    for (int a = 0; a < 2; ++a)
#pragma unroll
        for (int b = 0; b < 2; ++b)
#pragma unroll
            for (int m = 0; m < 4; ++m)
#pragma unroll
                for (int n = 0; n < 2; ++n) acc[a][b][m][n] = (f32x4){0.f, 0.f, 0.f, 0.f};
    bf16x8 At[4][2], B0[2][2], B1[2][2];
    const char* cA = (const char*)g.A + (size_t)cur.pm * tstep; const char* cB = (const char*)g.Bt + (size_t)cur.pn * tstep;
    S.a_ready(cur);
    if constexpr (SP2) {
        PG8_STAGE(PG8_SB(0, 0), cB, voffB); PG8_STAGE(PG8_SB(0, 1), cB + hstep, voffB); PG8_STAGE(PG8_SA(0, 0), cA, voffA); PG8_STAGE(PG8_SA(0, 1), cA + hstep, voffA);
        if (wr == 1) PG8_BAR;
        PG8_WAIT_V(2); PG8_BAR;
        PG8_STAGE(PG8_SB(1, 0), cB + kstep, voffB); PG8_STAGE(PG8_SA(1, 0), cA + kstep, voffA); PG8_STAGE(PG8_SB(1, 1), cB + hstep + kstep, voffB);
        PG8_WAIT_V(6); PG8_BAR;
    } else {
        PG8_STAGE(PG8_SB(0, 0), cB, voffB); PG8_STAGE(PG8_SA(0, 0), cA, voffA); PG8_STAGE(PG8_SB(0, 1), cB + hstep, voffB); PG8_STAGE(PG8_SA(0, 1), cA + hstep, voffA);
        if (wr == 1) PG8_BAR;
        PG8_WAIT_V(4); PG8_BAR;
        PG8_STAGE(PG8_SB(1, 0), cB + kstep, voffB); PG8_STAGE(PG8_SA(1, 0), cA + kstep, voffA); PG8_STAGE(PG8_SB(1, 1), cB + hstep + kstep, voffB);
        PG8_WAIT_V(6); PG8_BAR;
    }
    for (;;) {
        const bool has_next = S.next(ui + 1, nxt);
        const char* nA = has_next ? (const char*)g.A + (size_t)nxt.pm * tstep : cA; const char* nB = has_next ? (const char*)g.Bt + (size_t)nxt.pn * tstep : cB;
        for (int t = 0; t < nt; t += 2) {
            const bool last = (t == nt - 2);
            const char* a1 = cA + (size_t)(t + 1) * kstep;
            const char* a2 = last ? nA : cA + (size_t)(t + 2) * kstep; const char* b2 = last ? nB : cB + (size_t)(t + 2) * kstep;
            const char* a3 = a2 + kstep; const char* b3 = b2 + kstep;
            if (last && has_next) S.a_ready(nxt);
            if constexpr (SP2) {
            PG8_LDB(B0, 0, 0); PG8_LDB(B1, 0, 1); PG8_SCHED; PG8_LDA(At, 0, 0); PG8_STAGE(PG8_SA(1, 1), a1 + hstep, voffA);
            PG8_WAIT_V(8); PG8_WAIT_L(0); PG8_BAR; PG8_MMA(0, 0, At, B0); PG8_MMA(0, 1, At, B1); PG8_BAR; PG8_SCHED;
            PG8_LDA(At, 0, 1); PG8_STAGE(PG8_SB(0, 0), b2, voffB); PG8_STAGE(PG8_SB(0, 1), b2 + hstep, voffB); PG8_STAGE(PG8_SA(0, 0), a2, voffA);
            PG8_WAIT_V(8); PG8_WAIT_L(0); PG8_BAR; PG8_MMA(1, 0, At, B0); PG8_MMA(1, 1, At, B1); PG8_BAR; PG8_SCHED;
            PG8_LDB(B0, 1, 0); PG8_LDB(B1, 1, 1); PG8_SCHED; PG8_LDA(At, 1, 0); PG8_STAGE(PG8_SA(0, 1), a2 + hstep, voffA);
            PG8_WAIT_V(8); PG8_WAIT_L(0); PG8_BAR; PG8_MMA(0, 0, At, B0); PG8_MMA(0, 1, At, B1); PG8_BAR; PG8_SCHED;
            PG8_LDA(At, 1, 1); PG8_STAGE(PG8_SB(1, 0), b3, voffB); PG8_STAGE(PG8_SB(1, 1), b3 + hstep, voffB); PG8_STAGE(PG8_SA(1, 0), a3, voffA);
            PG8_WAIT_V(8); PG8_WAIT_L(0); PG8_BAR; PG8_MMA(1, 0, At, B0); PG8_MMA(1, 1, At, B1); PG8_BAR; PG8_SCHED;
            } else {
            PG8_LDB(B0, 0, 0); PG8_SCHED; PG8_LDA(At, 0, 0); PG8_STAGE(PG8_SA(1, 1), a1 + hstep, voffA);
            PG8_WAIT_L(8); PG8_BAR; PG8_WAIT_L(0); PG8_MMA(0, 0, At, B0); PG8_BAR; PG8_SCHED;
            PG8_LDB(B1, 0, 1); PG8_STAGE(PG8_SB(0, 0), b2, voffB);
            PG8_BAR; PG8_WAIT_L(0); PG8_MMA(0, 1, At, B1); PG8_BAR;
            PG8_LDA(At, 0, 1); PG8_STAGE(PG8_SA(0, 0), a2, voffA);
            PG8_BAR; PG8_WAIT_L(0); PG8_MMA(1, 0, At, B0); PG8_BAR; PG8_SCHED;
            PG8_STAGE(PG8_SB(0, 1), b2 + hstep, voffB);
            PG8_WAIT_V(6); PG8_BAR; PG8_MMA(1, 1, At, B1); PG8_BAR;
            PG8_LDB(B0, 1, 0); PG8_SCHED; PG8_LDA(At, 1, 0); PG8_STAGE(PG8_SA(0, 1), a2 + hstep, voffA);
            PG8_WAIT_L(8); PG8_BAR; PG8_WAIT_L(0); PG8_MMA(0, 0, At, B0); PG8_BAR; PG8_SCHED;
            PG8_LDB(B1, 1, 1); PG8_STAGE(PG8_SB(1, 0), b3, voffB);
            PG8_BAR; PG8_WAIT_L(0); PG8_MMA(0, 1, At, B1); PG8_BAR;
            PG8_LDA(At, 1, 1); PG8_STAGE(PG8_SA(1, 0), a3, voffA);
            PG8_BAR; PG8_WAIT_L(0); PG8_MMA(1, 0, At, B0); PG8_BAR; PG8_SCHED;
            PG8_STAGE(PG8_SB(1, 1), b3 + hstep, voffB);
            PG8_WAIT_V(6); PG8_BAR; PG8_MMA(1, 1, At, B1); PG8_BAR;
            }
        }
        if constexpr (ALIGN_EPI) { if (wr == 0) PG8_BAR; }
        if constexpr (!Epi::AFTER_DRAIN) { E(acc, cur, wr, wc, fr, fq); S.done(cur); }
        if (!has_next) break;
#pragma unroll
        for (int a = 0; a < 2; ++a)
#pragma unroll
            for (int b = 0; b < 2; ++b)
#pragma unroll
                for (int m = 0; m < 4; ++m)
#pragma unroll
                    for (int n = 0; n < 2; ++n) acc[a][b][m][n] = (f32x4){0.f, 0.f, 0.f, 0.f};
        cur = nxt; cA = nA; cB = nB; ++ui;
        if constexpr (ALIGN_EPI) { if (wr == 1) PG8_BAR; }
    }
    PG8_WAIT_V(0);
    if constexpr (!ALIGN_EPI) { if (wr == 0) PG8_BAR; }
    PG8_BAR;
    if constexpr (Epi::AFTER_DRAIN) { E.fused(acc, cur, wr, wc, fr, fq, lds, wid, lane); S.done(cur); }
#undef PG8_SA
#undef PG8_SB
#undef PG8_STAGE
#undef PG8_LDA
#undef PG8_LDB
#undef PG8_MMA
#undef PG8_WAIT_V
#undef PG8_WAIT_L
#undef PG8_BAR
#undef PG8_SCHED
}
}
#define LAS __attribute__((address_space(3)))
typedef unsigned short bf16;
typedef short bf16x8 __attribute__((ext_vector_type(8)));
typedef float f32x4 __attribute__((ext_vector_type(4)));
typedef float f32x16 __attribute__((ext_vector_type(16)));
typedef unsigned u32x4 __attribute__((ext_vector_type(4)));
typedef unsigned u32x2 __attribute__((ext_vector_type(2)));

constexpr int BATCH = 8, SEQ = 8192, DM = 1024, MTOK = BATCH * SEQ, FF = 2816, DEPTH = 2;
constexpr int QRANK = 384, KVRANK = 256, INCOLS = 1440, INPAD = 1536;
constexpr float EPS = 1e-6f, LOG2E = 1.4426950408889634f;
constexpr float QSCALE_A = 0.10206207261596575f * LOG2E;
constexpr float QSCALE_B = 0.125f * LOG2E;
constexpr int NWAVES = 8, NTHREADS = 512;
constexpr int LDS_BYTES = 147456;

constexpr size_t MiB = 1u << 20;
constexpr size_t CTL_ZERO_BYTES = 64 * 1024; constexpr int CW_GRP = 8192, CW_XM = 8704;
constexpr size_t WS_ROPE = 1 * MiB, WS_BTAB = 2 * MiB, WS_RS = 2 * MiB + 256 * 1024;
constexpr size_t WS_W = 4 * MiB, WL_BYTES = 40 * MiB;
constexpr size_t WO_GU1 = 0, WO_D1 = 11 * MiB, WO_GU2 = 16 * MiB + MiB / 2, WO_D2 = 27 * MiB + MiB / 2, WO_WIN = 33 * MiB, WO_UQ = 36 * MiB, WO_UKV = 37 * MiB, WO_OUT = 38 * MiB;
constexpr size_t WS_Y = 212 * MiB, WS_BIG = 340 * MiB;
constexpr size_t SLICE = 67 * MiB;
constexpr size_t OFF_ACT = 0;
constexpr size_t OFF_CQ = 0, OFF_CKV = 6 * MiB, OFF_KR = 10 * MiB, OFF_QB = 11 * MiB, OFF_KB = 19 * MiB, OFF_VB = 21 * MiB, OFF_Q = 23 * MiB, OFF_KN = 35 * MiB, OFF_V = 43 * MiB, OFF_O = 51 * MiB;
constexpr size_t WS_STAT = WS_BIG + 8 * SLICE, WS_XB = WS_STAT + 6 * MiB, WS_END = WS_XB + 128 * MiB;
#define GB(ws, grp, OFF, LD) ((ws) + WS_BIG + (size_t)(grp) * (SLICE - (size_t)SEQ * (LD) * 2) + (OFF))

__device__ __forceinline__ unsigned f2bf(float f) { unsigned u = __builtin_bit_cast(unsigned, f); return (u + 0x7fffu + ((u >> 16) & 1u)) >> 16; }
__device__ __forceinline__ unsigned pk2(float lo, float hi) { return f2bf(lo) | (f2bf(hi) << 16); }
__device__ __forceinline__ float bf2f(unsigned h) { return __builtin_bit_cast(float, h << 16); }
__device__ __forceinline__ float wave_sum(float v, int lane) {
#pragma unroll
    for (int o = 1; o < 64; o <<= 1) v += bperm_xor(v, lane, o);
    return v;
}

__device__ __forceinline__ int map_col(int mat, int r, const float* W0, const float* W1, const float*& src) {
    src = W0;
    switch (mat) {
    case 0: { const int t = r >> 8, w = r & 255; if (w >= 128) src = W1; return t * 128 + (w & 127); }
    case 2: { if (r >= INCOLS) return -1; if (r >= 640 && r < 672) { const int idx = r - 640; return 640 + (idx >> 1) + 16 * (idx & 1); } return r; }
    case 3: { const int h = r / 96, w = r % 96; if (w < 64) return h * 96 + w; const int idx = w - 64; return h * 96 + 64 + (idx >> 1) + 16 * (idx & 1); }
    case 4: { if (r < 512) return (r >> 6) * 128 + (r & 63); const int r2 = r - 512; return (r2 >> 6) * 128 + 64 + (r2 & 63); }
    default: return r;
    }
}
__device__ __forceinline__ void tr_item(int mat, const float* W0, const float* W1, int N, int K, int NP, const float* gk, bf16* WT, int item, LAS float* scr, int lane) {
    const int nblk = NP / 32, kb = item / nblk, nb = item % nblk, k0 = 64 * kb, n0 = 32 * nb;
    const float* src; const int col = map_col(mat, n0 + (lane & 31), W0, W1, src);
#pragma unroll 8
    for (int i = 0; i < 32; ++i) { const int kk = 2 * i + (lane >> 5); float v = 0.f; if (col >= 0) v = src[(size_t)(k0 + kk) * N + col]; if (gk) v *= gk[k0 + kk]; scr[kk * 33 + (lane & 31)] = v; }
    asm volatile("s_waitcnt lgkmcnt(0)" ::: "memory");
    const int c = lane & 7;
#pragma unroll
    for (int j = 0; j < 4; ++j) { const int n = (lane >> 3) + 8 * j; const LAS float* s = scr + (8 * c) * 33 + n;
        u32x4 o; o.x = pk2(s[0 * 33], s[1 * 33]); o.y = pk2(s[2 * 33], s[3 * 33]); o.z = pk2(s[4 * 33], s[5 * 33]); o.w = pk2(s[6 * 33], s[7 * 33]);
        *(u32x4*)(WT + (size_t)(n0 + n) * K + k0 + 8 * c) = o; }
    asm volatile("s_waitcnt lgkmcnt(0)" ::: "memory");
}

struct Args { const float* in[21]; float* out; unsigned char* ws; int pad0, pad1; };
typedef const Args __attribute__((address_space(4)))* ArgP;

__device__ __forceinline__ void row_to_bf16_rs(const float* xrow, bf16* orow, float* rs, int lane) {
    const f32x4* xr = (const f32x4*)xrow + lane; f32x4 v[4]; float s = 0.f;
#pragma unroll
    for (int j = 0; j < 4; ++j) { v[j] = __builtin_nontemporal_load(xr + 64 * j); s += (v[j][0] * v[j][0] + v[j][1] * v[j][1]) + (v[j][2] * v[j][2] + v[j][3] * v[j][3]); }
    const float rstd = __builtin_amdgcn_rsqf(wave_sum(s, lane) * (1.f / DM) + EPS);
#pragma unroll
    for (int j = 0; j < 4; ++j) { u32x2 o; o.x = pk2(v[j][0], v[j][1]); o.y = pk2(v[j][2], v[j][3]); ((u32x2*)orow)[lane + 64 * j] = o; }
    if (lane == 0) *rs = rstd;
}

__device__ __forceinline__ int t5_bucket(int rel) {
    const int n = rel < 0 ? -rel : rel; int b = rel > 0 ? 16 : 0;
    const float nf = (float)(n > 1 ? n : 1);
    int large = 8 + (int)(logf(nf / 8.0f) / 2.772588722239781f * 8.0f);
    large = large < 15 ? large : 15;
    return b + (n < 8 ? n : large);
}

__device__ __forceinline__ void prologue(ArgP a, LAS unsigned char* lds, int gw, int NGW, int lane, int wave) {
    LAS float* scr = (LAS float*)(lds + wave * 16384);
    unsigned char* ws = a->ws;
    constexpr int I_GU = 16 * 176, I_D = 44 * 32, I_WIN = 16 * 48, I_UQ = 6 * 24, I_UKV = 4 * 32, I_OUT = 16 * 32;
    constexpr int PER_L = 2 * I_GU + 2 * I_D + I_WIN + I_UQ + I_UKV + I_OUT;
    for (int it = gw; it < DEPTH * PER_L; it += NGW) {
        const int L = it / PER_L; int r = it % PER_L; unsigned char* wl = ws + WS_W + (size_t)L * WL_BYTES;
        if (r < I_GU) { tr_item(0, a->in[3] + (size_t)L * DM * FF, a->in[4] + (size_t)L * DM * FF, FF, DM, 2 * FF, a->in[2] + L * DM, (bf16*)(wl + WO_GU1), r, scr, lane); continue; } r -= I_GU;
        if (r < I_D) { tr_item(1, a->in[5] + (size_t)L * FF * DM, nullptr, DM, FF, DM, nullptr, (bf16*)(wl + WO_D1), r, scr, lane); continue; } r -= I_D;
        if (r < I_GU) { tr_item(0, a->in[17] + (size_t)L * DM * FF, a->in[18] + (size_t)L * DM * FF, FF, DM, 2 * FF, a->in[16] + L * DM, (bf16*)(wl + WO_GU2), r, scr, lane); continue; } r -= I_GU;
        if (r < I_D) { tr_item(1, a->in[19] + (size_t)L * FF * DM, nullptr, DM, FF, DM, nullptr, (bf16*)(wl + WO_D2), r, scr, lane); continue; } r -= I_D;
        if (r < I_WIN) { tr_item(2, a->in[8] + (size_t)L * DM * INCOLS, nullptr, INCOLS, DM, INPAD, a->in[7] + L * DM, (bf16*)(wl + WO_WIN), r, scr, lane); continue; } r -= I_WIN;
        if (r < I_UQ) { tr_item(3, a->in[10] + (size_t)L * QRANK * 768, nullptr, 768, QRANK, 768, a->in[9] + L * QRANK, (bf16*)(wl + WO_UQ), r, scr, lane); continue; } r -= I_UQ;
        if (r < I_UKV) { tr_item(4, a->in[12] + (size_t)L * KVRANK * 1024, nullptr, 1024, KVRANK, 1024, a->in[11] + L * KVRANK, (bf16*)(wl + WO_UKV), r, scr, lane); continue; } r -= I_UKV;
        tr_item(1, a->in[14] + (size_t)L * DM * DM, nullptr, DM, DM, DM, nullptr, (bf16*)(wl + WO_OUT), r, scr, lane);
    }
    float* rope = (float*)(ws + WS_ROPE);
    for (int e = gw * 64 + lane; e < SEQ * 16; e += NGW * 64) {
        const int pos = e >> 4, i = e & 15; const int i4 = i & 3, i16 = i >> 2;
        double inv = i4 == 0 ? 1.0 : i4 == 1 ? 0.5623413251903491 : i4 == 2 ? 0.31622776601683794 : 0.1778279410038923;
        inv *= i16 == 0 ? 1.0 : i16 == 1 ? 0.1 : i16 == 2 ? 0.01 : 0.001;
        const double rev = (double)pos * inv * 0.15915494309189535; const float fr = (float)(rev - floor(rev));
        rope[pos * 32 + i] = __builtin_amdgcn_cosf(fr); rope[pos * 32 + 16 + i] = __builtin_amdgcn_sinf(fr);
    }
    float* bt = (float*)(ws + WS_BTAB);
    for (int e = gw * 64 + lane; e < 8 * 260; e += NGW * 64) { const int h = e / 260, idx = e % 260; bt[e] = (idx >= 1 && idx <= 257) ? a->in[1][t5_bucket(idx - 129) * 8 + h] * LOG2E : -1e30f; }
    for (int m0 = gw; m0 < MTOK; m0 += 2 * NGW) {
        f32x4 v[2][4]; float s[2] = {0.f, 0.f};
#pragma unroll
        for (int q = 0; q < 2; ++q) { const f32x4* xr = (const f32x4*)(a->in[0] + (size_t)(m0 + q * NGW) * DM) + lane;
#pragma unroll
            for (int j = 0; j < 4; ++j) v[q][j] = __builtin_nontemporal_load(xr + 64 * j); }
#pragma unroll
        for (int q = 0; q < 2; ++q) { const int m = m0 + q * NGW;
#pragma unroll
            for (int j = 0; j < 4; ++j) { s[q] += (v[q][j][0] * v[q][j][0] + v[q][j][1] * v[q][j][1]) + (v[q][j][2] * v[q][j][2] + v[q][j][3] * v[q][j][3]);
                u32x2 o; o.x = pk2(v[q][j][0], v[q][j][1]); o.y = pk2(v[q][j][2], v[q][j][3]); ((u32x2*)((bf16*)(ws + WS_XB) + (size_t)m * DM))[lane + 64 * j] = o; } }
        const float r0 = __builtin_amdgcn_rsqf(wave_sum(s[0], lane) * (1.f / DM) + EPS), r1 = __builtin_amdgcn_rsqf(wave_sum(s[1], lane) * (1.f / DM) + EPS);
        if (lane == 0) { ((float*)(ws + WS_RS))[m0] = r0; ((float*)(ws + WS_RS))[m0 + NGW] = r1; }
    }
}

template <bool XIN_BF, bool XOUT_BF>
__device__ __forceinline__ void norm_pass(const bf16* Y, const void* xsrc_, void* xdst_, const float* gpost, float w, float* rs, int mstart, int mend, int mstep, int lane) {
    f32x4 gp[4];
#pragma unroll
    for (int j = 0; j < 4; ++j) gp[j] = ((const f32x4*)gpost)[lane + 64 * j] * w;
    for (int m0 = mstart; m0 < mend; m0 += 2 * mstep) {
        f32x4 y[2][4], x[2][4]; float s[2] = {0.f, 0.f};
#pragma unroll
        for (int q = 0; q < 2; ++q) { const int m = m0 + q * mstep; const u32x2* yr = (const u32x2*)(Y + (size_t)m * DM) + lane;
#pragma unroll
            for (int j = 0; j < 4; ++j) { const u32x2 t = __builtin_nontemporal_load(yr + 64 * j);
                if (XIN_BF) { const u32x2 tx = ((const u32x2*)((const bf16*)xsrc_ + (size_t)m * DM))[lane + 64 * j]; x[q][j][0] = bf2f(tx.x & 0xffffu); x[q][j][1] = bf2f(tx.x >> 16); x[q][j][2] = bf2f(tx.y & 0xffffu); x[q][j][3] = bf2f(tx.y >> 16); }
                else x[q][j] = __builtin_nontemporal_load((const f32x4*)((const float*)xsrc_ + (size_t)m * DM) + lane + 64 * j);
                y[q][j][0] = bf2f(t.x & 0xffffu); y[q][j][1] = bf2f(t.x >> 16); y[q][j][2] = bf2f(t.y & 0xffffu); y[q][j][3] = bf2f(t.y >> 16); } }
#pragma unroll
        for (int q = 0; q < 2; ++q)
#pragma unroll
            for (int j = 0; j < 4; ++j) s[q] += (y[q][j][0] * y[q][j][0] + y[q][j][1] * y[q][j][1]) + (y[q][j][2] * y[q][j][2] + y[q][j][3] * y[q][j][3]);
        float rstd[2]; rstd[0] = __builtin_amdgcn_rsqf(wave_sum(s[0], lane) * (1.f / DM) + EPS); rstd[1] = __builtin_amdgcn_rsqf(wave_sum(s[1], lane) * (1.f / DM) + EPS);
        float s2[2] = {0.f, 0.f};
#pragma unroll
        for (int q = 0; q < 2; ++q) { const int m = m0 + q * mstep;
#pragma unroll
            for (int j = 0; j < 4; ++j) { x[q][j] = x[q][j] + y[q][j] * gp[j] * rstd[q];
                if (XOUT_BF) { u32x2 o; o.x = pk2(x[q][j][0], x[q][j][1]); o.y = pk2(x[q][j][2], x[q][j][3]); ((u32x2*)((bf16*)xdst_ + (size_t)m * DM))[lane + 64 * j] = o; }
                else __builtin_nontemporal_store(x[q][j], (f32x4*)((float*)xdst_ + (size_t)m * DM) + lane + 64 * j);
                s2[q] += (x[q][j][0] * x[q][j][0] + x[q][j][1] * x[q][j][1]) + (x[q][j][2] * x[q][j][2] + x[q][j][3] * x[q][j][3]); } }
        if (rs) { const float r0 = __builtin_amdgcn_rsqf(wave_sum(s2[0], lane) * (1.f / DM) + EPS), r1 = __builtin_amdgcn_rsqf(wave_sum(s2[1], lane) * (1.f / DM) + EPS);
            if (lane == 0) { rs[m0] = r0; rs[m0 + mstep] = r1; } }
    }
}

constexpr int KROWB = 208, VROWB = 192, ATT_KBYTES = 64 * KROWB, ATT_VBYTES = 64 * VROWB, ATT_VBASE = 2 * ATT_KBYTES, ATT_BT_OFF = ATT_VBASE + 2 * ATT_VBYTES + 1024, ATT_OST_OFF = 61440;
struct AttnT { const bf16* Q; int ldq; const bf16* K; int ldk; const bf16* KR; const bf16* V; int ldv; bf16* O; };
typedef short v4i16_t __attribute__((ext_vector_type(4)));
__device__ __forceinline__ float hswap_max(float v) { auto rr = __builtin_amdgcn_permlane32_swap(__float_as_uint(v), __float_as_uint(v), false, false); return fmaxf(__uint_as_float(rr[0]), __uint_as_float(rr[1])); }
__device__ __forceinline__ float hswap_sum(float v) { auto rr = __builtin_amdgcn_permlane32_swap(__float_as_uint(v), __float_as_uint(v), false, false); return __uint_as_float(rr[0]) + __uint_as_float(rr[1]); }
typedef float f32x2_t __attribute__((ext_vector_type(2))); typedef __bf16 bf16x2_t __attribute__((ext_vector_type(2)));
__device__ __forceinline__ unsigned cvtpk(float lo, float hi) { f32x2_t v = {lo, hi}; bf16x2_t b = __builtin_convertvector(v, bf16x2_t); return __builtin_bit_cast(unsigned, b); }
__device__ __forceinline__ v4i16_t vtr(const LAS unsigned char* p) { return __builtin_amdgcn_ds_read_tr16_b64_v4i16((LAS v4i16_t*)p); }
#define ATT_SBAR() __builtin_amdgcn_sched_barrier(0)

template <int MODE>
__device__ __forceinline__ void attn_unit(LAS unsigned char* lds, const AttnT& T, int b, int q0, int qcol, int kcol, int vcol, int ocol, float sink_l2, const LAS float* btab, const int wv) {
    constexpr int KS = MODE == 0 ? 6 : 4;
    const int tid = opaque_tid(wv), lane = tid & 63, l32 = lane & 31, hi = lane >> 5; const int wid = __builtin_amdgcn_readfirstlane(tid >> 6);
    const size_t rowbase = (size_t)b * SEQ;
    if (wid >= 4) __builtin_amdgcn_s_setprio(1);
    bf16x8 qr[KS];
    { const bf16* qrow = T.Q + (rowbase + q0 + wid * 32 + l32) * T.ldq + qcol + hi * 8;
#pragma unroll
      for (int ks = 0; ks < KS; ++ks) qr[ks] = *(const bf16x8*)(qrow + ks * 16); }
    int kvs, NT;
    if (MODE == 0) { kvs = 0; NT = SEQ / 64; } else { const int tlo = q0 == 0 ? 2 : 0, thi = (q0 + 384 > SEQ) ? 6 : 8; kvs = q0 - 128 + 64 * tlo; NT = thi - tlo; }
    const int srow = tid >> 3, sc = tid & 7, rr = tid >> 2, rc = tid & 3; const bool rrole = MODE == 0 && tid < 256;
    const bf16* vsrc = T.V + (rowbase + kvs + srow) * T.ldv + vcol + 8 * sc;
    const bf16* ksrc = T.K + (rowbase + kvs + srow) * T.ldk + kcol + 8 * sc;
    const bf16* rsrc = MODE == 0 ? T.KR + (rowbase + kvs + rr) * 32 + 8 * rc : nullptr;
    u32x4 st0, st1, st2;
#define ATT_LOADK(t) do { st0 = *(const u32x4*)(ksrc + (size_t)(t) * 64 * T.ldk); if (rrole) st2 = *(const u32x4*)(rsrc + (size_t)(t) * 64 * 32); } while (0)
#define ATT_LOADV(t) do { st1 = *(const u32x4*)(vsrc + (size_t)(t) * 64 * T.ldv); } while (0)
#define ATT_STOREK(slot) do { LAS unsigned char* kb_ = lds + (slot) * ATT_KBYTES; *(LAS u32x4*)(kb_ + srow * KROWB + 16 * sc) = st0; if (rrole) *(LAS u32x4*)(kb_ + rr * KROWB + 128 + 16 * rc) = st2; } while (0)
#define ATT_STOREV(slot) do { *(LAS u32x4*)(lds + ATT_VBASE + (slot) * ATT_VBYTES + srow * VROWB + 16 * sc) = st1; } while (0)
    const int pim = (l32 & 0x13) | ((l32 & 4) << 1) | ((l32 & 8) >> 1);
    const int koff = pim * KROWB + hi * 16;
    const int voff = ATT_VBASE + (8 * hi + ((lane & 15) >> 2)) * VROWB + (16 * ((lane >> 4) & 1) + 4 * (lane & 3)) * 2;
    float mrun = MODE == 1 ? sink_l2 : 0.f, lsum = (MODE == 1 && hi == 0) ? 1.f : 0.f;
    f32x16 o0 = {}, o1 = {}, pA0, pA1, pB0, pB1, negm;
    const int qpos = q0 + wid * 32 + l32;
    bf16x8 kf[2 * KS]; v4i16_t vl[8], vh[8]; u32x4 w0, w1, w2, w3;
#define ATT_KREAD(slot) do { const LAS unsigned char* kb_ = lds + (slot) * ATT_KBYTES; \
        _Pragma("unroll") for (int ks = 0; ks < KS; ++ks) { kf[2 * ks] = *(const LAS bf16x8*)(kb_ + koff + ks * 32); kf[2 * ks + 1] = *(const LAS bf16x8*)(kb_ + koff + 32 * KROWB + ks * 32); } } while (0)
#define ATT_KRD(slot, ks) do { const LAS unsigned char* kb_ = lds + (slot) * ATT_KBYTES; kf[2 * (ks)] = *(const LAS bf16x8*)(kb_ + koff + (ks) * 32); kf[2 * (ks) + 1] = *(const LAS bf16x8*)(kb_ + koff + 32 * KROWB + (ks) * 32); } while (0)
#define ATT_VREAD(i, vb_) do { const LAS unsigned char* vp_ = (vb_) + voff + ((i) >> 1) * 16 * VROWB + ((i) & 1) * 64; vl[i] = vtr(vp_); vh[i] = vtr(vp_ + 4 * VROWB); } while (0)
#define ATT_VF(i) (bf16x8){vl[i][0], vl[i][1], vl[i][2], vl[i][3], vh[i][0], vh[i][1], vh[i][2], vh[i][3]}
#define ATT_MM(acc, a_, b_) acc = __builtin_amdgcn_mfma_f32_32x32x16_bf16(a_, b_, acc, 0, 0, 0)
#define ATT_EP(P, r, W, wi) do { P[r] = __builtin_amdgcn_exp2f(P[r]); P[(r) + 1] = __builtin_amdgcn_exp2f(P[(r) + 1]); lacc += P[r]; lacc += P[(r) + 1]; W[wi] = cvtpk(P[r], P[(r) + 1]); } while (0)
#define ATT_SM4(P0, P1, r, kvb_) do { if (MODE == 1) { _Pragma("unroll") for (int r_ = (r); r_ < (r) + 2; ++r_) { \
                const int j0 = (kvb_) + 16 * (r_ >> 3) + 8 * hi + (r_ & 7) - qpos + 129, j1 = j0 + 32; \
                const int i0 = j0 < 0 ? 0 : (j0 > 258 ? 258 : j0), i1 = j1 < 0 ? 0 : (j1 > 258 ? 258 : j1); \
                P0[r_] += btab[i0]; P1[r_] += btab[i1]; } } } while (0)
#define ATT_DECIDE(P0, P1, lacc_) do { const float lt_ = hswap_max(lacc_); \
        if (__any(lt_ > 65536.f)) { const float dl = lt_ > 65536.f ? (float)__builtin_amdgcn_frexp_expf(lt_) : 0.f, al = __builtin_amdgcn_exp2f(-dl); mrun += dl; lsum *= al; \
            _Pragma("unroll") for (int r = 0; r < 16; ++r) { o0[r] *= al; o1[r] *= al; P0[r] -= dl; P1[r] -= dl; negm[r] = -mrun; } } } while (0)
#define ATT_STEP(PC0, PC1, PN0, PN1, tt) do { \
        const int kslot_ = (tt) & 1; const bool kmore_ = (tt) + 2 < NT; const LAS unsigned char* vb_ = lds + ((tt) & 1) * ATT_VBYTES; const int kvn_ = kvs + 64 * ((tt) + 1); \
        if ((tt) + 3 < NT) ATT_LOADK((tt) + 3); ATT_LOADV((tt) + 1); \
        float lacc = 0.f; ATT_SBAR(); \
        PN0 = __builtin_amdgcn_mfma_f32_32x32x16_bf16(kf[0], qr[0], negm, 0, 0, 0); ATT_EP(PC0, 0, w0, 0); ATT_EP(PC0, 2, w0, 1); ATT_SBAR(); \
        PN1 = __builtin_amdgcn_mfma_f32_32x32x16_bf16(kf[1], qr[0], negm, 0, 0, 0); ATT_EP(PC0, 4, w0, 2); ATT_EP(PC0, 6, w0, 3); ATT_SBAR(); \
        ATT_MM(PN0, kf[2], qr[1]); ATT_EP(PC0, 8, w1, 0); ATT_EP(PC0, 10, w1, 1); ATT_SBAR(); \
        ATT_MM(PN1, kf[3], qr[1]); ATT_EP(PC0, 12, w1, 2); ATT_EP(PC0, 14, w1, 3); ATT_SBAR(); \
        ATT_MM(PN0, kf[4], qr[2]); ATT_EP(PC1, 0, w2, 0); ATT_VREAD(0, vb_); ATT_VREAD(1, vb_); ATT_SBAR(); \
        ATT_MM(PN1, kf[5], qr[2]); ATT_EP(PC1, 2, w2, 1); ATT_VREAD(2, vb_); ATT_SBAR(); \
        ATT_MM(PN0, kf[6], qr[3]); ATT_EP(PC1, 4, w2, 2); ATT_VREAD(3, vb_); ATT_SBAR(); \
        ATT_MM(PN1, kf[7], qr[3]); ATT_EP(PC1, 6, w2, 3); ATT_VREAD(4, vb_); ATT_SBAR(); \
        if (KS > 4) { ATT_MM(PN0, kf[2 * KS - 4], qr[KS - 2]); ATT_EP(PC1, 8, w3, 0); ATT_VREAD(5, vb_); ATT_SBAR(); \
                      ATT_MM(PN1, kf[2 * KS - 3], qr[KS - 2]); ATT_EP(PC1, 10, w3, 1); ATT_VREAD(6, vb_); ATT_SBAR(); \
                      ATT_MM(PN0, kf[2 * KS - 2], qr[KS - 1]); ATT_EP(PC1, 12, w3, 2); ATT_VREAD(7, vb_); ATT_SBAR(); \
                      ATT_MM(PN1, kf[2 * KS - 1], qr[KS - 1]); ATT_EP(PC1, 14, w3, 3); ATT_SBAR(); } \
        else { ATT_EP(PC1, 8, w3, 0); ATT_EP(PC1, 10, w3, 1); ATT_VREAD(5, vb_); ATT_VREAD(6, vb_); ATT_EP(PC1, 12, w3, 2); ATT_EP(PC1, 14, w3, 3); ATT_VREAD(7, vb_); ATT_SBAR(); } \
        lsum += lacc; \
        ATT_MM(o0, ATT_VF(0), __builtin_bit_cast(bf16x8, w0)); ATT_SM4(PN0, PN1, 0, kvn_); if (kmore_) ATT_KRD(kslot_, 0); ATT_SBAR(); \
        ATT_MM(o1, ATT_VF(1), __builtin_bit_cast(bf16x8, w0)); ATT_SM4(PN0, PN1, 2, kvn_); if (kmore_) ATT_KRD(kslot_, 1); ATT_SBAR(); \
        ATT_MM(o0, ATT_VF(2), __builtin_bit_cast(bf16x8, w1)); ATT_SM4(PN0, PN1, 4, kvn_); if (kmore_) ATT_KRD(kslot_, 2); ATT_SBAR(); \
        ATT_MM(o1, ATT_VF(3), __builtin_bit_cast(bf16x8, w1)); ATT_SM4(PN0, PN1, 6, kvn_); if (kmore_) ATT_KRD(kslot_, 3); ATT_SBAR(); \
        ATT_MM(o0, ATT_VF(4), __builtin_bit_cast(bf16x8, w2)); ATT_SM4(PN0, PN1, 8, kvn_); if (KS > 4) { if (kmore_) ATT_KRD(kslot_, KS - 2); } ATT_SBAR(); \
        ATT_MM(o1, ATT_VF(5), __builtin_bit_cast(bf16x8, w2)); ATT_SM4(PN0, PN1, 10, kvn_); if (KS > 4) { if (kmore_) ATT_KRD(kslot_, KS - 1); } ATT_SBAR(); \
        ATT_MM(o0, ATT_VF(6), __builtin_bit_cast(bf16x8, w3)); ATT_SM4(PN0, PN1, 12, kvn_); ATT_SBAR(); \
        ATT_MM(o1, ATT_VF(7), __builtin_bit_cast(bf16x8, w3)); ATT_SM4(PN0, PN1, 14, kvn_); ATT_SBAR(); \
        ATT_DECIDE(PN0, PN1, lacc); \
        if ((tt) + 3 < NT) ATT_STOREK(((tt) + 1) & 1); ATT_STOREV(((tt) + 1) & 1); \
        __syncthreads(); } while (0)
    ATT_LOADK(0); ATT_LOADV(0); ATT_STOREK(0); ATT_STOREV(0); ATT_LOADK(1); ATT_STOREK(1);
    __syncthreads();
    ATT_KREAD(0); ATT_SBAR();
    pA0 = __builtin_amdgcn_mfma_f32_32x32x16_bf16(kf[0], qr[0], (f32x16){}, 0, 0, 0); pA1 = __builtin_amdgcn_mfma_f32_32x32x16_bf16(kf[1], qr[0], (f32x16){}, 0, 0, 0);
#pragma unroll
    for (int ks = 1; ks < KS; ++ks) { ATT_MM(pA0, kf[2 * ks], qr[ks]); ATT_MM(pA1, kf[2 * ks + 1], qr[ks]); }
#pragma unroll
    for (int r = 0; r < 16; ++r) { pA0[r] -= mrun; pA1[r] -= mrun; }
#pragma unroll
    for (int r = 0; r < 16; r += 2) ATT_SM4(pA0, pA1, r, kvs);
    if (MODE == 0) {
        float rm = fmaxf(fmaxf(pA0[0], pA1[0]), fmaxf(pA0[1], pA1[1]));
#pragma unroll
        for (int r = 2; r < 16; r += 2) rm = fmaxf(fmaxf(rm, fmaxf(pA0[r], pA1[r])), fmaxf(pA0[r + 1], pA1[r + 1]));
        rm = hswap_max(rm); mrun = rm;
#pragma unroll
        for (int r = 0; r < 16; ++r) { pA0[r] -= rm; pA1[r] -= rm; }
    }
#pragma unroll
    for (int r = 0; r < 16; ++r) negm[r] = -mrun;
    ATT_KREAD(1);
    __syncthreads();
    ATT_LOADK(2); ATT_STOREK(0);
    __syncthreads();
    for (int t = 0; t + 2 < NT; t += 2) { ATT_STEP(pA0, pA1, pB0, pB1, t); ATT_STEP(pB0, pB1, pA0, pA1, t + 1); }
    ATT_STEP(pA0, pA1, pB0, pB1, NT - 2);
    {
        const LAS unsigned char* vb_ = lds + ((NT - 1) & 1) * ATT_VBYTES; float lacc = 0.f;
#pragma unroll
        for (int i = 0; i < 8; ++i) ATT_VREAD(i, vb_);
        ATT_EP(pB0, 0, w0, 0); ATT_EP(pB0, 2, w0, 1); ATT_EP(pB0, 4, w0, 2); ATT_EP(pB0, 6, w0, 3); ATT_EP(pB0, 8, w1, 0); ATT_EP(pB0, 10, w1, 1); ATT_EP(pB0, 12, w1, 2); ATT_EP(pB0, 14, w1, 3);
        ATT_EP(pB1, 0, w2, 0); ATT_EP(pB1, 2, w2, 1); ATT_EP(pB1, 4, w2, 2); ATT_EP(pB1, 6, w2, 3); ATT_EP(pB1, 8, w3, 0); ATT_EP(pB1, 10, w3, 1); ATT_EP(pB1, 12, w3, 2); ATT_EP(pB1, 14, w3, 3);
        lsum += lacc;
        ATT_MM(o0, ATT_VF(0), __builtin_bit_cast(bf16x8, w0)); ATT_MM(o1, ATT_VF(1), __builtin_bit_cast(bf16x8, w0)); ATT_MM(o0, ATT_VF(2), __builtin_bit_cast(bf16x8, w1)); ATT_MM(o1, ATT_VF(3), __builtin_bit_cast(bf16x8, w1));
        ATT_MM(o0, ATT_VF(4), __builtin_bit_cast(bf16x8, w2)); ATT_MM(o1, ATT_VF(5), __builtin_bit_cast(bf16x8, w2)); ATT_MM(o0, ATT_VF(6), __builtin_bit_cast(bf16x8, w3)); ATT_MM(o1, ATT_VF(7), __builtin_bit_cast(bf16x8, w3));
        __syncthreads();
    }
#undef ATT_LOADK
#undef ATT_LOADV
#undef ATT_STOREK
#undef ATT_STOREV
#undef ATT_KREAD
#undef ATT_VREAD
#undef ATT_VF
#undef ATT_MM
#undef ATT_EP
#undef ATT_SM4
#undef ATT_DECIDE
#undef ATT_STEP
    __builtin_amdgcn_s_setprio(0);
    const float inv = 1.0f / hswap_sum(lsum);
    const int lane2 = opaque_tid(wv) & 63, l32b = lane2 & 31, hib = lane2 >> 5;
    LAS unsigned char* stg = lds + ATT_OST_OFF + wid * (32 * 144);
#pragma unroll
    for (int g = 0; g < 4; ++g) {
        u32x2 a, c; a.x = cvtpk(o0[4 * g] * inv, o0[4 * g + 1] * inv); a.y = cvtpk(o0[4 * g + 2] * inv, o0[4 * g + 3] * inv);
        c.x = cvtpk(o1[4 * g] * inv, o1[4 * g + 1] * inv); c.y = cvtpk(o1[4 * g + 2] * inv, o1[4 * g + 3] * inv);
        *(LAS u32x2*)(stg + l32b * 144 + (8 * g + 4 * hib) * 2) = a; *(LAS u32x2*)(stg + l32b * 144 + 64 + (8 * g + 4 * hib) * 2) = c;
    }
    bf16* obase = T.O + (rowbase + q0 + wid * 32) * DM + ocol;
#pragma unroll
    for (int i = 0; i < 4; ++i) { const int row = i * 8 + (lane2 >> 3), ch = lane2 & 7;
        const u32x4 v = *(const LAS u32x4*)(stg + row * 144 + ch * 16); *(u32x4*)(obase + (size_t)row * DM + ch * 8) = v; }
}
__device__ __forceinline__ void group_barrier(unsigned* word, unsigned& gen, unsigned nmem, const int wv, const bool xlocal) {
    asm volatile("s_waitcnt vmcnt(0)" ::: "memory");
    __syncthreads();
    if (opaque_tid(wv) == 0) {
        if (!xlocal) __builtin_amdgcn_fence(__ATOMIC_RELEASE, "agent");
        asm volatile("s_waitcnt vmcnt(0)" ::: "memory");
        const unsigned want = nmem * (gen + 1u);
        (void)__hip_atomic_fetch_add(word, 1u, __ATOMIC_RELAXED, __HIP_MEMORY_SCOPE_AGENT);
        unsigned sp = 0u;
        while (__hip_atomic_load(word, __ATOMIC_RELAXED, __HIP_MEMORY_SCOPE_AGENT) < want) { __builtin_amdgcn_s_sleep(1); if (++sp > (1u << 22)) break; }
        __builtin_amdgcn_fence(__ATOMIC_ACQUIRE, "agent");
        asm volatile("s_waitcnt vmcnt(0)" ::: "memory");
    }
    gen += 1u;
    __syncthreads();
}

#ifndef MK_SYNC
#define MK_SYNC() group_barrier(gword, ggen, gmem, wv, xlocal)
#endif
#define ARGP() ({ ArgP p_ = (ArgP)__builtin_amdgcn_kernarg_segment_ptr(); asm volatile("" : "+s"(p_)); p_; })
#define PH_IDS() const int tid = opaque_tid(wv), lane = tid & 63; const int wave = __builtin_amdgcn_readfirstlane(tid >> 6); const int gw = vcu * NWAVES + wave, NGW = G * NWAVES; (void)lane; (void)gw; (void)NGW
__global__ void __launch_bounds__(NTHREADS) mk_fwd(Args a_unused) {
    extern __shared__ __attribute__((aligned(16))) unsigned char lds_raw[];
    LAS unsigned char* lds = (LAS unsigned char*)lds_raw;
    cg::grid_group grid = cg::this_grid();
    const int wv = __builtin_amdgcn_readfirstlane(threadIdx.x >> 6);
    const int G = gridDim.x, bx = blockIdx.x; const int vcu = (G % 8 == 0) ? (bx % 8) * (G / 8) + bx / 8 : bx;
    const int grp = bx & 7, lcu = bx >> 3;
    unsigned* gword = (unsigned*)(ARGP()->ws) + CW_GRP + 64 * grp; unsigned ggen = 0u; const unsigned gmem = 32u;
    if (threadIdx.x == 0) { const unsigned xcc = (unsigned)__builtin_amdgcn_s_getreg((3 << 11) | 20) & 0xFu; (void)__hip_atomic_fetch_or((unsigned*)(ARGP()->ws) + CW_XM + 64 * grp, 1u << xcc, __ATOMIC_RELAXED, __HIP_MEMORY_SCOPE_AGENT); }

    { PH_IDS(); ArgP ap = ARGP(); prologue(ap, lds, gw, NGW, lane, wave); }
    grid.sync();
    const bool xlocal = __builtin_popcount(__builtin_amdgcn_readfirstlane(__hip_atomic_load((unsigned*)(ARGP()->ws) + CW_XM + 64 * grp, __ATOMIC_RELAXED, __HIP_MEMORY_SCOPE_AGENT))) == 1;
    for (int L = 0; L < DEPTH; ++L) {
        for (int f = 0; f < 2; ++f) {
            { ArgP ap = ARGP(); unsigned char* ws = ap->ws; const unsigned char* wl = ws + WS_W + (size_t)L * WL_BYTES;
              pg8::Gemm g{(const bf16*)(ws + WS_XB), (const bf16*)(wl + (f ? WO_GU2 : WO_GU1)), MTOK, 2 * FF, DM}; pg8::StaticOrder S; S.init(MTOK, 2 * FF, G, bx);
              pg8::EpiSwiGLU E{(bf16*)(GB(ws, grp, OFF_ACT, FF)), FF, (const float*)(ws + WS_RS)}; pg8::gemm_phase<pg8::EpiSwiGLU, pg8::StaticOrder, true, true>(lds, g, S, E, wv); }
            MK_SYNC();
            { ArgP ap = ARGP(); unsigned char* ws = ap->ws; const unsigned char* wl = ws + WS_W + (size_t)L * WL_BYTES;
              pg8::Gemm g{(const bf16*)(GB(ws, grp, OFF_ACT, FF)), (const bf16*)(wl + (f ? WO_D2 : WO_D1)), MTOK, DM, FF}; pg8::StaticOrder S; S.init(MTOK, DM, G, bx);
              pg8::EpiStore E{(bf16*)(ws + WS_Y), DM}; pg8::gemm_phase<pg8::EpiStore, pg8::StaticOrder, true, true>(lds, g, S, E, wv); }
            MK_SYNC();
            { PH_IDS(); ArgP ap = ARGP(); unsigned char* ws = ap->ws; bf16* XB = (bf16*)(ws + WS_XB);
              const int mstart = SEQ * grp + lcu * NWAVES + wave, mend = SEQ * (grp + 1), mstep = 32 * NWAVES;
              const float* gpost = f ? ap->in[20] + L * DM : ap->in[6] + L * DM; float* rs = (float*)(ws + WS_RS);
              if (L == DEPTH - 1 && f == 1) norm_pass<true, false>((const bf16*)(ws + WS_Y), XB, ap->out, gpost, 0.5f, nullptr, mstart, mend, mstep, lane);
              else norm_pass<true, true>((const bf16*)(ws + WS_Y), XB, XB, gpost, 0.5f, rs, mstart, mend, mstep, lane); }
            if (f == 1) { if (L + 1 < DEPTH) MK_SYNC(); continue; }
            MK_SYNC();
            { ArgP ap = ARGP(); unsigned char* ws = ap->ws; const unsigned char* wl = ws + WS_W + (size_t)L * WL_BYTES;
              pg8::Gemm g{(const bf16*)(ws + WS_XB), (const bf16*)(wl + WO_WIN), MTOK, INPAD, DM}; pg8::StaticOrder S; S.init(MTOK, INPAD, G, bx);
              pg8::EpiWin E{(bf16*)(GB(ws, grp, OFF_CQ, 384)), (bf16*)(GB(ws, grp, OFF_CKV, 256)), (bf16*)(GB(ws, grp, OFF_KR, 32)), (bf16*)(GB(ws, grp, OFF_QB, 512)), (bf16*)(GB(ws, grp, OFF_KB, 128)), (bf16*)(GB(ws, grp, OFF_VB, 128)), (float*)(ws + WS_STAT), (const float*)(ws + WS_ROPE), QSCALE_B, (const float*)(ws + WS_RS)};
              pg8::gemm_phase<pg8::EpiWin, pg8::StaticOrder, true, true>(lds, g, S, E, wv); }
            MK_SYNC();
            { ArgP ap = ARGP(); unsigned char* ws = ap->ws; const unsigned char* wl = ws + WS_W + (size_t)L * WL_BYTES;
              pg8::Gemm g{(const bf16*)(GB(ws, grp, OFF_CQ, 384)), (const bf16*)(wl + WO_UQ), MTOK, 768, QRANK}; pg8::StaticOrder S; S.init(MTOK, 768, G, bx);
              pg8::EpiUq E{(bf16*)(GB(ws, grp, OFF_Q, 768)), (const float*)(ws + WS_STAT), (const float*)(ws + WS_ROPE), QSCALE_A}; pg8::gemm_phase<pg8::EpiUq, pg8::StaticOrder, true, true>(lds, g, S, E, wv); }
            { ArgP ap = ARGP(); unsigned char* ws = ap->ws; const unsigned char* wl = ws + WS_W + (size_t)L * WL_BYTES;
              pg8::Gemm g{(const bf16*)(GB(ws, grp, OFF_CKV, 256)), (const bf16*)(wl + WO_UKV), MTOK, 1024, KVRANK}; pg8::StaticOrder S; S.init(MTOK, 1024, G, bx);
              pg8::EpiUkv E{(bf16*)(GB(ws, grp, OFF_KN, 512)), (bf16*)(GB(ws, grp, OFF_V, 512)), (const float*)(ws + WS_STAT)}; pg8::gemm_phase<pg8::EpiUkv, pg8::StaticOrder, true, true>(lds, g, S, E, wv); }
            {
              PH_IDS(); ArgP ap = ARGP(); unsigned char* ws = ap->ws; const float* btab = (const float*)(ws + WS_BTAB); const float* sink = ap->in[13] + L * 8;
              LAS float* bt = (LAS float*)(lds + ATT_BT_OFF);
              for (int e = tid; e < 8 * 260; e += NTHREADS) bt[e] = btab[e];
              __syncthreads();
              const AttnT T{(const bf16*)(GB(ws, grp, OFF_QB, 512)), 512, (const bf16*)(GB(ws, grp, OFF_KB, 128)), 128, nullptr, (const bf16*)(GB(ws, grp, OFF_VB, 128)), 128, (bf16*)(GB(ws, grp, OFF_O, 1024))};
              for (int u = lcu; u < 256; u += 32) { const int h = u >> 5, qb = u & 31, b = grp;
                  attn_unit<1>(lds, T, b, qb * 256, h * 64, (h >> 2) * 64, (h >> 2) * 64, 512 + h * 64, sink[h] * LOG2E, bt + h * 260, wv); } }
            MK_SYNC();
            { ArgP ap = ARGP(); unsigned char* ws = ap->ws;
              const AttnT T{(const bf16*)(GB(ws, grp, OFF_Q, 768)), 768, (const bf16*)(GB(ws, grp, OFF_KN, 512)), 512, (const bf16*)(GB(ws, grp, OFF_KR, 32)), (const bf16*)(GB(ws, grp, OFF_V, 512)), 512, (bf16*)(GB(ws, grp, OFF_O, 1024))};
              for (int u = lcu; u < 256; u += 32) { const int h = u >> 5, qb = u & 31, b = grp;
                  attn_unit<0>(lds, T, b, qb * 256, h * 96, h * 64, h * 64, h * 64, 0.f, nullptr, wv); } }
            MK_SYNC();
            { ArgP ap = ARGP(); unsigned char* ws = ap->ws; const unsigned char* wl = ws + WS_W + (size_t)L * WL_BYTES;
              pg8::Gemm g{(const bf16*)(GB(ws, grp, OFF_O, 1024)), (const bf16*)(wl + WO_OUT), MTOK, DM, DM}; pg8::StaticOrder S; S.init(MTOK, DM, G, bx);
              pg8::EpiStore E{(bf16*)(ws + WS_Y), DM}; pg8::gemm_phase<pg8::EpiStore, pg8::StaticOrder, true, true>(lds, g, S, E, wv); }
            MK_SYNC();
            { PH_IDS(); ArgP ap = ARGP(); unsigned char* ws = ap->ws; bf16* XB = (bf16*)(ws + WS_XB);
              const int mstart = SEQ * grp + lcu * NWAVES + wave, mend = SEQ * (grp + 1), mstep = 32 * NWAVES;
              norm_pass<true, true>((const bf16*)(ws + WS_Y), XB, XB, ap->in[15] + L * DM, 1.0f, (float*)(ws + WS_RS), mstart, mend, mstep, lane); }
            MK_SYNC();
        }
    }
}

extern "C" void kernel_launch(void* const* d_in, const int* in_sizes, int n_in, void* d_out, int out_size, void* d_ws, size_t ws_size, hipStream_t stream) {
    static int grid = 0;
    if (grid == 0) {
        if (n_in != 21 || in_sizes[0] != MTOK * DM || out_size != MTOK * DM || ws_size < WS_END) { fprintf(stderr, "kernel_launch: unexpected shapes / workspace (n_in %d, ws %zu)\n", n_in, ws_size); grid = -1; return; }
        int dev = 0, cus = 0, per_cu = 0;
        (void)hipGetDevice(&dev); (void)hipDeviceGetAttribute(&cus, hipDeviceAttributeMultiprocessorCount, dev);
        (void)hipFuncSetAttribute((const void*)mk_fwd, hipFuncAttributeMaxDynamicSharedMemorySize, LDS_BYTES);
        if (hipOccupancyMaxActiveBlocksPerMultiprocessor(&per_cu, (const void*)mk_fwd, NTHREADS, LDS_BYTES) != hipSuccess || per_cu < 1) per_cu = 1;
        (void)hipGetLastError();
        grid = cus * per_cu;
        if (grid < 256) { fprintf(stderr, "kernel_launch: this kernel needs 256 co-resident workgroups (got %d)\n", grid); grid = -1; return; }
        grid = 256;
    }
    if (grid < 0) return;
    if (hipMemsetAsync(d_ws, 0, CTL_ZERO_BYTES, stream) != hipSuccess) { fprintf(stderr, "kernel_launch: memset of the barrier words failed\n"); return; }
    Args a{};
    for (int i = 0; i < 21; ++i) a.in[i] = (const float*)d_in[i];
    a.out = (float*)d_out; a.ws = (unsigned char*)d_ws;
    void* args[] = {&a};
    hipError_t e = hipLaunchCooperativeKernel((const void*)mk_fwd, dim3(grid), dim3(NTHREADS), args, LDS_BYTES, stream);
    if (e != hipSuccess) fprintf(stderr, "cooperative launch failed: %s (grid %d)\n", hipGetErrorString(e), grid);
}
```
